# Optimizing an MI355X kernel written in HIP

```python
import functools
import jax, jax.numpy as jnp
from jax import lax
import numpy as np

D_MODEL = 1024
BATCH = 2
SEQ = 8192
DEPTH = 1
DEC_BATCH = 128
DEC_SEQ = 8
PAST_LEN = 8192
PAGE_SIZE = 128

N_HEADS = 8
QK_NOPE = 64
QK_ROPE = 32
V_HEAD = 64
Q_RANK = 384
KV_RANK = 256
MLA_WIDTH = N_HEADS * V_HEAD
QK_SCALE = (QK_NOPE + QK_ROPE) ** -0.5
ROPE_BASE = 10000.0
Q_BLOCK = 128
N_GROUPS = 8
GROUP_DIM = 64
GMLP_WIDTH = N_GROUPS * GROUP_DIM
CHUNK = 128
OFF_KV = Q_RANK
OFF_KR = OFF_KV + KV_RANK
OFF_G = OFF_KR + QK_ROPE
IN_COLS = OFF_G + 2 * GMLP_WIDTH
MIX_WIDTH = MLA_WIDTH + GMLP_WIDTH
D_FF = -(-8 * D_MODEL // (3 * 256)) * 256
EPS = 1e-6

kernel_name = "hymba_mla_gmlp_decoder_step"


def rmsnorm(x, g):
    xf = x.astype(jnp.float32)
    y = xf * lax.rsqrt(jnp.mean(xf * xf, axis=-1, keepdims=True) + EPS)
    return (y * g.astype(jnp.float32)).astype(x.dtype)


def layernorm(x, g, b):
    xf = x.astype(jnp.float32)
    mu = jnp.mean(xf, axis=-1, keepdims=True)
    xc = xf - mu
    y = xc * lax.rsqrt(jnp.mean(xc * xc, axis=-1, keepdims=True) + EPS)
    return (y * g.astype(jnp.float32) + b.astype(jnp.float32)).astype(x.dtype)


def rope(x, pos):
    half = QK_ROPE // 2
    inv = ROPE_BASE ** (-jnp.arange(half, dtype=jnp.float32) / half)
    ang = pos.astype(jnp.float32)[:, None] * inv[None, :]
    bshape = (ang.shape[0],) + (1,) * (x.ndim - 3) + (half,)
    c = jnp.cos(ang).reshape(bshape)
    s = jnp.sin(ang).reshape(bshape)
    xf = x.astype(jnp.float32)
    x1, x2 = xf[..., :half], xf[..., half:]
    return jnp.concatenate([x1 * c - x2 * s, x1 * s + x2 * c], axis=-1).astype(x.dtype)


def mixer_front(h, pos, w_in, q_norm_g, w_q_up, kv_norm_g, w_uk, v_norm_g, v_norm_b):
    B, S, _ = h.shape
    z = h @ w_in
    c_q = z[..., :OFF_KV]
    c_kv = rmsnorm(z[..., OFF_KV:OFF_KR], kv_norm_g)
    k_r = rope(z[..., OFF_KR:OFF_G], pos)
    q = (rmsnorm(c_q, q_norm_g) @ w_q_up).reshape(B, S, N_HEADS, QK_NOPE + QK_ROPE)
    q_lat = jnp.einsum('bshn,rhn->bshr', q[..., :QK_NOPE], w_uk) * QK_SCALE
    q_rope = rope(q[..., QK_NOPE:], pos) * QK_SCALE
    zg = jax.nn.gelu(z[..., OFF_G:], approximate=False)
    u = zg[..., :GMLP_WIDTH]
    v = layernorm(zg[..., GMLP_WIDTH:], v_norm_g, v_norm_b)
    return q_lat, q_rope, c_kv, k_r, u, v


def mla_prompt_attend(q_lat, q_rope, c_kv, k_r):
    B, S = q_lat.shape[:2]
    nb = S // Q_BLOCK
    ql = q_lat.reshape(B, nb, Q_BLOCK, N_HEADS, KV_RANK).transpose(1, 0, 2, 3, 4)
    qr = q_rope.reshape(B, nb, Q_BLOCK, N_HEADS, QK_ROPE).transpose(1, 0, 2, 3, 4)
    kpos = jnp.arange(S)

    def block(args):
        i, qlb, qrb = args
        s = (jnp.einsum('bqhr,bkr->bhqk', qlb, c_kv)
             + jnp.einsum('bqhp,bkp->bhqk', qrb, k_r)).astype(jnp.float32)
        qpos = i * Q_BLOCK + jnp.arange(Q_BLOCK)
        s = jnp.where(kpos[None, :] <= qpos[:, None], s, -jnp.inf)
        p = jax.nn.softmax(s, axis=-1).astype(c_kv.dtype)
        return jnp.einsum('bhqk,bkr->bqhr', p, c_kv)

    o = lax.map(block, (jnp.arange(nb), ql, qr))
    return o.transpose(1, 0, 2, 3, 4).reshape(B, S, N_HEADS, KV_RANK)


def mla_sample_attend(q_lat, q_rope, c_kv, k_r, cache_ckv, cache_krope, page_table, layer):
    DB, T = q_lat.shape[:2]
    past_c = cache_ckv[layer, page_table].reshape(DB, -1, KV_RANK)
    past_r = cache_krope[layer, page_table].reshape(DB, -1, QK_ROPE)
    P = past_c.shape[1]
    s_past = (jnp.einsum('bqhr,bkr->bhqk', q_lat, past_c)
              + jnp.einsum('bqhp,bkp->bhqk', q_rope, past_r)).astype(jnp.float32)
    s_new = (jnp.einsum('bqhr,bkr->bhqk', q_lat, c_kv)
             + jnp.einsum('bqhp,bkp->bhqk', q_rope, k_r)).astype(jnp.float32)
    causal = jnp.tril(jnp.ones((T, T), dtype=bool))
    s_new = jnp.where(causal, s_new, -jnp.inf)
    p = jax.nn.softmax(jnp.concatenate([s_past, s_new], axis=-1), axis=-1).astype(c_kv.dtype)
    return (jnp.einsum('bhqk,bkr->bqhr', p[..., :P], past_c)
            + jnp.einsum('bhqk,bkr->bqhr', p[..., P:], c_kv))


def spatial_gate(u, v, w_s, b_s):
    B, S, _ = v.shape
    L = min(S, CHUNK)
    nc = S // L
    w = jnp.where(jnp.tril(jnp.ones((L, L), dtype=bool)), w_s[:, :L, :L], 0)
    vc = v.reshape(B, nc, L, N_GROUPS, GROUP_DIM)
    mix = jnp.einsum('gij,bcjgd->bcigd', w, vc) + b_s[:, :L].T[None, None, :, :, None]
    return u * mix.reshape(B, S, GMLP_WIDTH)


def trunk_layer(x, pos, attend, norm1_g, w_in, q_norm_g, w_q_up, kv_norm_g, w_uk, w_uv,
                v_norm_g, v_norm_b, w_spatial, b_spatial, out_norm_mla_g, out_norm_gmlp_g,
                w_out, norm2_g, w_gate, w_up, w_down):
    B, S, _ = x.shape
    h = rmsnorm(x, norm1_g)
    q_lat, q_rope, c_kv, k_r, u, v = mixer_front(h, pos, w_in, q_norm_g, w_q_up, kv_norm_g,
                                                 w_uk, v_norm_g, v_norm_b)
    o_lat = attend(q_lat, q_rope, c_kv, k_r)
    a = jnp.einsum('bshr,rhv->bshv', o_lat, w_uv).reshape(B, S, MLA_WIDTH)
    g = spatial_gate(u, v, w_spatial, b_spatial)
    merged = jnp.concatenate([rmsnorm(a, out_norm_mla_g), rmsnorm(g, out_norm_gmlp_g)], axis=-1)
    x = x + merged @ w_out
    h2 = rmsnorm(x, norm2_g)
    x = x + (jax.nn.silu(h2 @ w_gate) * (h2 @ w_up)) @ w_down
    return x, c_kv, k_r, v


def setup_inputs(seed: int = 0) -> dict:
    key = jax.random.key(seed)
    ks = iter(jax.random.split(key, 32))
    f32 = jnp.float32

    def nrm(shape, scale):
        return jax.random.normal(next(ks), shape, f32) * scale

    def gain(shape):
        return 1.0 + 0.05 * jax.random.normal(next(ks), shape, f32)

    n_pages = PAST_LEN // PAGE_SIZE
    n_used = DEC_BATCH * n_pages
    n_pool = n_used + (n_used + 3) // 4
    page_table = jax.random.permutation(next(ks), n_pool)[:n_used].reshape(DEC_BATCH, n_pages).astype(jnp.int32)

    return {
        "x_prompt": nrm((BATCH, SEQ, D_MODEL), 1.0),
        "x_sample": nrm((DEC_BATCH, DEC_SEQ, D_MODEL), 1.0),
        "cache_ckv": nrm((DEPTH, n_pool, PAGE_SIZE, KV_RANK), 1.0),
        "cache_krope": nrm((DEPTH, n_pool, PAGE_SIZE, QK_ROPE), 1.0),
        "page_table": page_table,
        "norm1_g": gain((DEPTH, D_MODEL)),
        "w_in": nrm((DEPTH, D_MODEL, IN_COLS), D_MODEL ** -0.5),
        "q_norm_g": gain((DEPTH, Q_RANK)),
        "w_q_up": nrm((DEPTH, Q_RANK, N_HEADS * (QK_NOPE + QK_ROPE)), Q_RANK ** -0.5),
        "kv_norm_g": gain((DEPTH, KV_RANK)),
        "w_uk": nrm((DEPTH, KV_RANK, N_HEADS, QK_NOPE), KV_RANK ** -0.5),
        "w_uv": nrm((DEPTH, KV_RANK, N_HEADS, V_HEAD), KV_RANK ** -0.5),
        "v_norm_g": gain((DEPTH, GMLP_WIDTH)),
        "v_norm_b": nrm((DEPTH, GMLP_WIDTH), 0.02),
        "w_spatial": nrm((DEPTH, N_GROUPS, CHUNK, CHUNK), CHUNK ** -0.5),
        "b_spatial": 1.0 + nrm((DEPTH, N_GROUPS, CHUNK), 0.1),
        "out_norm_mla_g": gain((DEPTH, MLA_WIDTH)),
        "out_norm_gmlp_g": gain((DEPTH, GMLP_WIDTH)),
        "w_out": nrm((DEPTH, MIX_WIDTH, D_MODEL), MIX_WIDTH ** -0.5),
        "norm2_g": gain((DEPTH, D_MODEL)),
        "w_gate": nrm((DEPTH, D_MODEL, D_FF), D_MODEL ** -0.5),
        "w_up": nrm((DEPTH, D_MODEL, D_FF), D_MODEL ** -0.5),
        "w_down": nrm((DEPTH, D_FF, D_MODEL), D_FF ** -0.5),
        "final_norm_g": gain((D_MODEL,)),
    }


def reference(x_prompt, x_sample, cache_ckv, cache_krope, page_table, norm1_g, w_in, q_norm_g,
              w_q_up, kv_norm_g, w_uk, w_uv, v_norm_g, v_norm_b, w_spatial, b_spatial,
              out_norm_mla_g, out_norm_gmlp_g, w_out, norm2_g, w_gate, w_up, w_down, final_norm_g):
    S = x_prompt.shape[1]
    T = x_sample.shape[1]
    pos_p = jnp.arange(S)
    pos_s = PAST_LEN + jnp.arange(T)
    xp, xs = x_prompt, x_sample
    ckv_p, kr_p, ckv_s, kr_s, v_s = [], [], [], [], []
    for l in range(DEPTH):
        lw = (norm1_g[l], w_in[l], q_norm_g[l], w_q_up[l], kv_norm_g[l], w_uk[l], w_uv[l],
              v_norm_g[l], v_norm_b[l], w_spatial[l], b_spatial[l], out_norm_mla_g[l],
              out_norm_gmlp_g[l], w_out[l], norm2_g[l], w_gate[l], w_up[l], w_down[l])
        xp, c1, r1, _ = trunk_layer(xp, pos_p, mla_prompt_attend, *lw)
        attend_s = functools.partial(mla_sample_attend, cache_ckv=cache_ckv, cache_krope=cache_krope,
                                     page_table=page_table, layer=l)
        xs, c2, r2, v2 = trunk_layer(xs, pos_s, attend_s, *lw)
        ckv_p.append(c1)
        kr_p.append(r1)
        ckv_s.append(c2)
        kr_s.append(r2)
        v_s.append(v2)
    y_prompt = rmsnorm(xp, final_norm_g)
    y_sample = rmsnorm(xs, final_norm_g)
    ckv_prompt = jnp.stack(ckv_p)
    krope_prompt = jnp.stack(kr_p)
    ckv_sample = jnp.stack(ckv_s)
    krope_sample = jnp.stack(kr_s)
    gmlp_v_sample = jnp.stack(v_s)
    return (y_prompt, y_sample, ckv_prompt, krope_prompt, ckv_sample, krope_sample, gmlp_v_sample)
```

```cpp
#include <hip/hip_runtime.h>
#include <cstdio>
#include <cstdint>
__device__ __forceinline__ int lane_now() { int l; asm volatile("v_mbcnt_lo_u32_b32 %0, -1, 0\n\tv_mbcnt_hi_u32_b32 %0, -1, %0" : "=v"(l)); return l; }
namespace pg8 {
#define PG8_LAS __attribute__((address_space(3)))
typedef unsigned short bf16_t;
typedef short bf16x8 __attribute__((ext_vector_type(8)));
typedef float f32x4 __attribute__((ext_vector_type(4)));
typedef unsigned u32x4 __attribute__((ext_vector_type(4)));
constexpr int BM = 256, BK = 64, HALF = 128, HTB = HALF * BK * 2  , STAGE_BYTES = 8 * HTB, NXCD = 8, WGM = 8;

__host__ __device__ __forceinline__ int lds_byte(int r, int c) { const int st = (r >> 4) * 2 + (c >> 5), rr = r & 15, cc = c & 31, ob = rr * 64 + cc * 2; return st * 1024 + (ob ^ (((ob >> 9) & 1) << 5)); }
__host__ __device__ __forceinline__ void stage_rc(int b, int& R, int& C) { const int st = b / 1024, sb = b % 1024, swz = sb ^ (((sb >> 9) & 1) << 5); R = (st >> 1) * 16 + swz / 64; C = (st & 1) * 32 + (swz % 64) / 2; }
__host__ __device__ __forceinline__ int perm32(int rho) { const int n = rho >> 4, i = rho & 15; return 8 * (i >> 2) + 4 * n + (i & 3); }

struct Unit { int pm, pn; };
struct Gemm { const bf16_t* A; const bf16_t* Bt; int M, N, K; };

struct StaticOrder {
    int nM, nN, nwg, G, c;
    __host__ __device__ void init(int M, int N, int G_, int c_) { nM = M / BM; nN = N / BM; nwg = nM * nN; G = G_; c = c_; }
    __host__ __device__ bool next(int i, Unit& u) const {
        const long L = (long)i * G + c; if (L >= nwg) return false;
        int wgid = (int)L; { const int q = nwg / NXCD, r = nwg % NXCD, xcd = wgid % NXCD, off = wgid / NXCD; wgid = (xcd < r ? xcd * (q + 1) : r * (q + 1) + (xcd - r) * q) + off; }
        const int nig = WGM * nN, gid = wgid / nig, fm = gid * WGM, gsz = (nM - fm) < WGM ? (nM - fm) : WGM;
        u.pm = fm + ((wgid % nig) % gsz); u.pn = (wgid % nig) / gsz; return true;
    }
    __device__ __forceinline__ void a_ready(const Unit&) const {}
    __device__ __forceinline__ void done(const Unit&) const {}
};

__device__ __forceinline__ unsigned cvt_pk_bf16(float lo, float hi) { unsigned r; asm volatile("v_cvt_pk_bf16_f32 %0, %1, %2" : "=v"(r) : "v"(lo), "v"(hi)); return r; }
typedef float f32x2 __attribute__((ext_vector_type(2)));
__device__ __forceinline__ f32x2 gelu_pk(f32x2 v) {
    const f32x2 av = __builtin_elementwise_abs(v), d = av * 0.2316418882f + 1.0f;
    f32x2 t; t.x = __builtin_amdgcn_rcpf(d.x); t.y = __builtin_amdgcn_rcpf(d.y);
    f32x2 q = t * 0.5307027145f + (-0.7265760135f); q = q * t + 0.7107068705f; q = q * t + (-0.142248368f); q = q * t + 0.127414796f; q = q * t;
    const f32x2 s = (v * v) * (-0.72134752044f);
    f32x2 e; e.x = __builtin_amdgcn_exp2f(s.x); e.y = __builtin_amdgcn_exp2f(s.y);
    const f32x2 m = v * (q * e), r = v - m;
    f32x2 o; o.x = v.x < 0.f ? m.x : r.x; o.y = v.y < 0.f ? m.y : r.y; return o;
}

template <int ACT  > struct EpiBf16 {
    static constexpr bool PERM = true, AFTER_DRAIN = false; static_assert(ACT == 0 || ACT == 1, "EpiBf16: ACT is 0 (none) or 1 (gelu_pk)");
    bf16_t* O; int ldc; const float* bias; int split_cols; size_t split_stride; float scale0;
    __device__ __forceinline__ void operator()(const f32x4 (&acc)[2][2][4][2], const Unit& u, int wr, int wc, int fr, int fq) const {
        const int row0 = u.pm * BM + wr * 64 + fr; int colt = u.pn * BM; bf16_t* base = O;
        float sc = 1.f; if (split_cols) { const int t = colt / split_cols; base += (size_t)t * split_stride; colt -= t * split_cols; if (t == 0) sc = scale0; }
        const int col0 = colt + wc * 32 + 8 * fq, bcol0 = u.pn * BM + wc * 32 + 8 * fq;
        f32x4 bv[2][2];
#pragma unroll
        for (int bj = 0; bj < 2; ++bj)
#pragma unroll
            for (int n = 0; n < 2; ++n) bv[bj][n] = bias ? *(const f32x4*)(bias + bcol0 + bj * HALF + 4 * n) : (f32x4){0.f, 0.f, 0.f, 0.f};
#pragma unroll
        for (int ai = 0; ai < 2; ++ai)
#pragma unroll
            for (int m = 0; m < 4; ++m) { bf16_t* rowp = base + (size_t)(row0 + ai * HALF + m * 16) * ldc + col0;
#pragma unroll
                for (int bj = 0; bj < 2; ++bj) { f32x4 v0 = acc[ai][bj][m][0] + bv[bj][0], v1 = acc[ai][bj][m][1] + bv[bj][1];
                    if (ACT == 1) { f32x2 a = gelu_pk((f32x2){v0[0], v0[1]}), b = gelu_pk((f32x2){v0[2], v0[3]}), c = gelu_pk((f32x2){v1[0], v1[1]}), d = gelu_pk((f32x2){v1[2], v1[3]});
                        v0 = (f32x4){a.x, a.y, b.x, b.y}; v1 = (f32x4){c.x, c.y, d.x, d.y}; }
                    v0 = v0 * sc; v1 = v1 * sc; u32x4 w; w.x = cvt_pk_bf16(v0[0], v0[1]); w.y = cvt_pk_bf16(v0[2], v0[3]); w.z = cvt_pk_bf16(v1[0], v1[1]); w.w = cvt_pk_bf16(v1[2], v1[3]);
                    *(u32x4*)(rowp + bj * HALF) = w; } }
    }
};

struct EpiQ {
    static constexpr bool PERM = true, AFTER_DRAIN = false;
    bf16_t* O; const float* rope; float qscale;
    __device__ __forceinline__ void operator()(const f32x4 (&acc)[2][2][4][2], const Unit& u, int wr, int wc, int fr, int fq) const {
        const int row0 = u.pm * BM + wr * 64 + fr, cg0 = u.pn * BM + wc * 32, col0 = cg0 + 8 * fq;
        const bool rp0 = (cg0 % 96) >= 64, rp1 = ((cg0 + HALF) % 96) >= 64;
        const bool prompt = u.pm < 64;
        const float* tp0 = rope + ((size_t)(prompt ? (row0 & 8191) : 8192 + (row0 & 7)) * 16 + 4 * fq) * 2; const int tstride = prompt ? 32 : 0;
#pragma unroll
        for (int ai = 0; ai < 2; ++ai)
#pragma unroll
            for (int m = 0; m < 4; ++m) { const int dr = ai * HALF + m * 16; bf16_t* rowp = O + (size_t)(row0 + dr) * 768 + col0;
#pragma unroll
                for (int bj = 0; bj < 2; ++bj) { f32x4 v0 = acc[ai][bj][m][0], v1 = acc[ai][bj][m][1];
                    if (bj == 0 ? rp0 : rp1) {
                        const f32x4 t0 = *(const f32x4*)(tp0 + dr * tstride), t1 = *(const f32x4*)(tp0 + dr * tstride + 4);
                        const f32x4 a = v0, b = v1;
                        v0[0] = a[0] * t0[0] - a[1] * t0[1]; v0[1] = a[0] * t0[1] + a[1] * t0[0]; v0[2] = a[2] * t0[2] - a[3] * t0[3]; v0[3] = a[2] * t0[3] + a[3] * t0[2];
                        v1[0] = b[0] * t1[0] - b[1] * t1[1]; v1[1] = b[0] * t1[1] + b[1] * t1[0]; v1[2] = b[2] * t1[2] - b[3] * t1[3]; v1[3] = b[2] * t1[3] + b[3] * t1[2];
                    }
                    v0 = v0 * qscale; v1 = v1 * qscale; u32x4 w; w.x = cvt_pk_bf16(v0[0], v0[1]); w.y = cvt_pk_bf16(v0[2], v0[3]); w.z = cvt_pk_bf16(v1[0], v1[1]); w.w = cvt_pk_bf16(v1[2], v1[3]);
                    *(u32x4*)(rowp + bj * HALF) = w; }
                asm volatile("" ::: "memory"); }
    }
};
struct EpiResF32 {
    static constexpr bool PERM = false, AFTER_DRAIN = false;
    const float* base_p; const float* base_s; float* out; int ldc;
    __device__ __forceinline__ void operator()(const f32x4 (&acc)[2][2][4][2], const Unit& u, int wr, int wc, int fr, int fq) const {
        const int row0 = u.pm * BM + wr * 64 + fr, col0 = u.pn * BM + wc * 32 + 4 * fq;
        const float* base = (u.pm < 64) ? base_p : base_s - (size_t)16384 * ldc;
#pragma unroll
        for (int ai = 0; ai < 2; ++ai)
#pragma unroll
            for (int m = 0; m < 4; ++m) { const size_t off = (size_t)(row0 + ai * HALF + m * 16) * ldc + col0;
#pragma unroll
                for (int bj = 0; bj < 2; ++bj)
#pragma unroll
                    for (int n = 0; n < 2; ++n) { const f32x4 b = *(const f32x4*)(base + off + bj * HALF + n * 16); *(f32x4*)(out + off + bj * HALF + n * 16) = b + acc[ai][bj][m][n]; }
                if (m & 1) asm volatile("" ::: "memory"); }
    }
};
struct EpiSwiGLU {
    static constexpr bool PERM = true, AFTER_DRAIN = false;
    bf16_t* H; int ldh;
    static __device__ __forceinline__ float silu_mul(float g, float u) { return g * __builtin_amdgcn_rcpf(1.0f + __builtin_amdgcn_exp2f(-1.4426950408889634f * g)) * u; }
    __device__ __forceinline__ void operator()(const f32x4 (&acc)[2][2][4][2], const Unit& u, int wr, int wc, int fr, int fq) const {
        const int row0 = u.pm * BM + wr * 64 + fr, col0 = u.pn * HALF + wc * 32 + 8 * fq;
#pragma unroll
        for (int ai = 0; ai < 2; ++ai)
#pragma unroll
            for (int m = 0; m < 4; ++m) {
                const f32x4 g0 = acc[ai][0][m][0], g1 = acc[ai][0][m][1], u0 = acc[ai][1][m][0], u1 = acc[ai][1][m][1];
                u32x4 w;
                w.x = cvt_pk_bf16(silu_mul(g0[0], u0[0]), silu_mul(g0[1], u0[1])); w.y = cvt_pk_bf16(silu_mul(g0[2], u0[2]), silu_mul(g0[3], u0[3]));
                w.z = cvt_pk_bf16(silu_mul(g1[0], u1[0]), silu_mul(g1[1], u1[1])); w.w = cvt_pk_bf16(silu_mul(g1[2], u1[2]), silu_mul(g1[3], u1[3]));
                *(u32x4*)(H + (size_t)(row0 + ai * HALF + m * 16) * ldh + col0) = w;
            }
    }
};

template <class Epi, class Sched, bool ALIGN_EPI = false, bool SP2 = false>
__device__ __forceinline__ void gemm_phase(PG8_LAS unsigned char* lds, const Gemm g, const Sched& S, const Epi& E, int wid_s  ) {
    const int wid = wid_s, lane = lane_now(), tid = wid * 64 + lane, wr = wid >> 2, wc = wid & 3, fr = lane & 15, fq = lane >> 4;
    const int K = g.K, nt = K / BK;
    unsigned voffA[2], voffB[2];
#pragma unroll
    for (int i = 0; i < 2; ++i) { int R, C; stage_rc(tid * 16 + i * 8192, R, C); const int Rb = Epi::PERM ? ((R & ~31) + perm32(R & 31)) : R;
        voffA[i] = (unsigned)(R * K + C) * 2u; voffB[i] = (unsigned)(Rb * K + C) * 2u; }
    const size_t kstep = (size_t)(BK * 2);
    const size_t hstep = (size_t)HALF * K * 2;
    const size_t tstep = 2 * hstep;
    const unsigned ldsw = (unsigned)wid * 1024u;
    const int aoff = lds_byte(wr * 64 + fr, fq * 8), boff = lds_byte(wc * 32 + fr, fq * 8);
#define PG8_SA(b, h) (((b) * 2 + (h)) * HTB)
#define PG8_SB(b, h) ((4 + (b) * 2 + (h)) * HTB)
#define PG8_STAGE(bufoff, gbase, voff) do { _Pragma("unroll") for (int _i = 0; _i < 2; ++_i) \
        __builtin_amdgcn_global_load_lds((const unsigned*)((const char*)(gbase) + (voff)[_i]), (PG8_LAS unsigned*)(lds + (bufoff) + ldsw + _i * 8192), 16, 0, 0); } while (0)
#define PG8_LDA(dst, b, h) do { _Pragma("unroll") for (int m = 0; m < 4; ++m) _Pragma("unroll") for (int k = 0; k < 2; ++k) dst[m][k] = *(const PG8_LAS bf16x8*)(lds + PG8_SA(b, h) + aoff + m * 2048 + k * 1024); } while (0)
#define PG8_LDB(dst, b, h) do { _Pragma("unroll") for (int n = 0; n < 2; ++n) _Pragma("unroll") for (int k = 0; k < 2; ++k) dst[n][k] = *(const PG8_LAS bf16x8*)(lds + PG8_SB(b, h) + boff + n * 2048 + k * 1024); } while (0)
#define PG8_MMA(ai, bj, At, Bt) do { __builtin_amdgcn_s_setprio(1); _Pragma("unroll") for (int m = 0; m < 4; ++m) _Pragma("unroll") for (int n = 0; n < 2; ++n) _Pragma("unroll") for (int k = 0; k < 2; ++k) \
        acc[ai][bj][m][n] = __builtin_amdgcn_mfma_f32_16x16x32_bf16(Bt[n][k], At[m][k], acc[ai][bj][m][n], 0, 0, 0); __builtin_amdgcn_s_setprio(0); } while (0)
#define PG8_WAIT_V(n) asm volatile("s_waitcnt vmcnt(" #n ")" ::: "memory")
#define PG8_WAIT_L(n) asm volatile("s_waitcnt lgkmcnt(" #n ")" ::: "memory")
#define PG8_BAR __builtin_amdgcn_s_barrier()
#define PG8_SCHED __builtin_amdgcn_sched_barrier(0)
    Unit cur, nxt; int ui = 0;
    if (!S.next(0, cur)) return;
    f32x4 acc[2][2][4][2];
#pragma unroll
    for (int a = 0; a < 2; ++a)
#pragma unroll
        for (int b = 0; b < 2; ++b)
#pragma unroll
            for (int m = 0; m < 4; ++m)
#pragma unroll
                for (int n = 0; n < 2; ++n) acc[a][b][m][n] = (f32x4){0.f, 0.f, 0.f, 0.f};
    bf16x8 At[4][2], B0[2][2], B1[2][2];
    const char* cA = (const char*)g.A + (size_t)cur.pm * tstep; const char* cB = (const char*)g.Bt + (size_t)cur.pn * tstep;
    S.a_ready(cur);
    if constexpr (SP2) {
        PG8_STAGE(PG8_SB(0, 0), cB, voffB); PG8_STAGE(PG8_SB(0, 1), cB + hstep, voffB); PG8_STAGE(PG8_SA(0, 0), cA, voffA); PG8_STAGE(PG8_SA(0, 1), cA + hstep, voffA);
        if (wr == 1) PG8_BAR;
        PG8_WAIT_V(2); PG8_BAR;
        PG8_STAGE(PG8_SB(1, 0), cB + kstep, voffB); PG8_STAGE(PG8_SA(1, 0), cA + kstep, voffA); PG8_STAGE(PG8_SB(1, 1), cB + hstep + kstep, voffB);
        PG8_WAIT_V(6); PG8_BAR;
    } else {
        PG8_STAGE(PG8_SB(0, 0), cB, voffB); PG8_STAGE(PG8_SA(0, 0), cA, voffA); PG8_STAGE(PG8_SB(0, 1), cB + hstep, voffB); PG8_STAGE(PG8_SA(0, 1), cA + hstep, voffA);
        if (wr == 1) PG8_BAR;
        PG8_WAIT_V(4); PG8_BAR;
        PG8_STAGE(PG8_SB(1, 0), cB + kstep, voffB); PG8_STAGE(PG8_SA(1, 0), cA + kstep, voffA); PG8_STAGE(PG8_SB(1, 1), cB + hstep + kstep, voffB);
        PG8_WAIT_V(6); PG8_BAR;
    }
    for (;;) {
        const bool has_next = S.next(ui + 1, nxt);
        const char* nA = has_next ? (const char*)g.A + (size_t)nxt.pm * tstep : cA; const char* nB = has_next ? (const char*)g.Bt + (size_t)nxt.pn * tstep : cB;
_Pragma("unroll 1")
        for (int t = 0; t < nt; t += 2) {
            const bool last = (t == nt - 2);
            const char* a1 = cA + (size_t)(t + 1) * kstep;
            const char* a2 = last ? nA : cA + (size_t)(t + 2) * kstep; const char* b2 = last ? nB : cB + (size_t)(t + 2) * kstep;
            const char* a3 = a2 + kstep; const char* b3 = b2 + kstep;
            if (last && has_next) S.a_ready(nxt);
            if constexpr (SP2) {
            PG8_LDB(B0, 0, 0); PG8_LDB(B1, 0, 1); PG8_SCHED; PG8_LDA(At, 0, 0); PG8_STAGE(PG8_SA(1, 1), a1 + hstep, voffA);
            PG8_WAIT_V(8); PG8_WAIT_L(0); PG8_BAR; PG8_MMA(0, 0, At, B0); PG8_MMA(0, 1, At, B1); PG8_BAR; PG8_SCHED;
            PG8_LDA(At, 0, 1); PG8_STAGE(PG8_SB(0, 0), b2, voffB); PG8_STAGE(PG8_SB(0, 1), b2 + hstep, voffB); PG8_STAGE(PG8_SA(0, 0), a2, voffA);
            PG8_WAIT_V(8); PG8_WAIT_L(0); PG8_BAR; PG8_MMA(1, 0, At, B0); PG8_MMA(1, 1, At, B1); PG8_BAR; PG8_SCHED;
            PG8_LDB(B0, 1, 0); PG8_LDB(B1, 1, 1); PG8_SCHED; PG8_LDA(At, 1, 0); PG8_STAGE(PG8_SA(0, 1), a2 + hstep, voffA);
            PG8_WAIT_V(8); PG8_WAIT_L(0); PG8_BAR; PG8_MMA(0, 0, At, B0); PG8_MMA(0, 1, At, B1); PG8_BAR; PG8_SCHED;
            PG8_LDA(At, 1, 1); PG8_STAGE(PG8_SB(1, 0), b3, voffB); PG8_STAGE(PG8_SB(1, 1), b3 + hstep, voffB); PG8_STAGE(PG8_SA(1, 0), a3, voffA);
            PG8_WAIT_V(8); PG8_WAIT_L(0); PG8_BAR; PG8_MMA(1, 0, At, B0); PG8_MMA(1, 1, At, B1); PG8_BAR; PG8_SCHED;
            } else {
            PG8_LDB(B0, 0, 0); PG8_SCHED; PG8_LDA(At, 0, 0); PG8_STAGE(PG8_SA(1, 1), a1 + hstep, voffA);
            PG8_WAIT_L(8); PG8_BAR; PG8_WAIT_L(0); PG8_MMA(0, 0, At, B0); PG8_BAR; PG8_SCHED;
            PG8_LDB(B1, 0, 1); PG8_STAGE(PG8_SB(0, 0), b2, voffB);
            PG8_BAR; PG8_WAIT_L(0); PG8_MMA(0, 1, At, B1); PG8_BAR;
            PG8_LDA(At, 0, 1); PG8_STAGE(PG8_SA(0, 0), a2, voffA);
            PG8_BAR; PG8_WAIT_L(0); PG8_MMA(1, 0, At, B0); PG8_BAR; PG8_SCHED;
            PG8_STAGE(PG8_SB(0, 1), b2 + hstep, voffB);
            PG8_WAIT_V(6); PG8_BAR; PG8_MMA(1, 1, At, B1); PG8_BAR;
            PG8_LDB(B0, 1, 0); PG8_SCHED; PG8_LDA(At, 1, 0); PG8_STAGE(PG8_SA(0, 1), a2 + hstep, voffA);
            PG8_WAIT_L(8); PG8_BAR; PG8_WAIT_L(0); PG8_MMA(0, 0, At, B0); PG8_BAR; PG8_SCHED;
            PG8_LDB(B1, 1, 1); PG8_STAGE(PG8_SB(1, 0), b3, voffB);
            PG8_BAR; PG8_WAIT_L(0); PG8_MMA(0, 1, At, B1); PG8_BAR;
            PG8_LDA(At, 1, 1); PG8_STAGE(PG8_SA(1, 0), a3, voffA);
            PG8_BAR; PG8_WAIT_L(0); PG8_MMA(1, 0, At, B0); PG8_BAR; PG8_SCHED;
            PG8_STAGE(PG8_SB(1, 1), b3 + hstep, voffB);
            PG8_WAIT_V(6); PG8_BAR; PG8_MMA(1, 1, At, B1); PG8_BAR;
            }
        }
        if constexpr (ALIGN_EPI) { if (wr == 0) PG8_BAR; }
        if constexpr (!Epi::AFTER_DRAIN) { E(acc, cur, wr, wc, fr, fq); S.done(cur); }
        if (!has_next) break;
#pragma unroll
        for (int a = 0; a < 2; ++a)
#pragma unroll
            for (int b = 0; b < 2; ++b)
#pragma unroll
                for (int m = 0; m < 4; ++m)
#pragma unroll
                    for (int n = 0; n < 2; ++n) acc[a][b][m][n] = (f32x4){0.f, 0.f, 0.f, 0.f};
        cur = nxt; cA = nA; cB = nB; ++ui;
        if constexpr (ALIGN_EPI) { if (wr == 1) PG8_BAR; }
    }
    PG8_WAIT_V(0);
    if constexpr (!ALIGN_EPI) { if (wr == 0) PG8_BAR; }
    PG8_BAR;
    if constexpr (Epi::AFTER_DRAIN) { E.fused(acc, cur, wr, wc, fr, fq, lds, wid, lane); S.done(cur); }
#undef PG8_SA
#undef PG8_SB
#undef PG8_STAGE
#undef PG8_LDA
#undef PG8_LDB
#undef PG8_MMA
#undef PG8_WAIT_V
#undef PG8_WAIT_L
#undef PG8_BAR
#undef PG8_SCHED
}
}

#ifndef PG8_SP2
#define PG8_SP2 true
#endif
#ifndef PG8_ALIGN
#define PG8_ALIGN true
#endif
#include <hip/hip_bf16.h>
#include <cmath>
namespace attn_body {
using bf16=__hip_bfloat16;
using bf16x8=__attribute__((ext_vector_type(8)))short;
using s16x4=__attribute__((ext_vector_type(4)))short;
using f32x16=__attribute__((ext_vector_type(16)))float;
using u32x4=__attribute__((ext_vector_type(4)))unsigned;
constexpr int BATCH=2,NHEAD=8,SEQ=8192,D=64,DQK=96,DM=NHEAD*D,QPITCH=NHEAD*DQK,KRP=32;
constexpr int NW=8,QBLK=32,QB=QBLK*NW,KVBLK=64,NQB=SEQ/QB;
constexpr int ATTN_PITCH=DM, ATTN_UNIT_ROWS=QB;
__device__ __forceinline__ int crow(int r,int hi){return (r&3)+8*(r>>2)+4*hi;}
__device__ __forceinline__ f32x16 splat16(float v){return (f32x16){v,v,v,v,v,v,v,v,v,v,v,v,v,v,v,v};}
#define SBAR() __builtin_amdgcn_sched_barrier(0)
__device__ __forceinline__ void cmask(f32x16&p0,f32x16&p1,int jb,int qrel,int hi){
  const float NEG=-INFINITY; int kb=64*jb+4*hi;
  #pragma unroll
  for(int r=0;r<16;++r){int kv=kb+(r&3)+8*(r>>2); if(kv>qrel)p0[r]=NEG; if(kv+32>qrel)p1[r]=NEG;}
}

constexpr int NSLOT=3, SLOTB=8192, KSLOTB=12288;
constexpr int LDS_K=0, LDS_V=NSLOT*KSLOTB, LDS_WS=LDS_V+NSLOT*SLOTB, LDS_OST=LDS_WS+NW*64*4, LDS_BYTES=LDS_OST+NW*4096;
constexpr float C2=0.10206207261596575f*1.4426950408889634f;
__device__ __forceinline__ void glds16(const void*gsrc,unsigned lds_dst){unsigned keep;
  asm volatile("s_mov_b32 %0, m0\n\ts_mov_b32 m0, %2\n\ts_nop 0\n\tglobal_load_lds_dwordx4 %1, off\n\ts_mov_b32 m0, %0":"=&s"(keep):"v"(gsrc),"s"(lds_dst):"memory");}
__device__ __forceinline__ float max3f(float a,float b,float c){float r;asm("v_max3_f32 %0, %1, %2, %3":"=v"(r):"v"(a),"v"(b),"v"(c));return r;}
__device__ __forceinline__ float max2f(float a,float b){float r;asm("v_max_f32_e32 %0, %1, %2":"=v"(r):"v"(a),"v"(b));return r;}
__device__ __forceinline__ float fadd_s(float a,float b){float r;asm("v_add_f32_e32 %0, %1, %2":"=v"(r):"v"(a),"v"(b));return r;}
__device__ __forceinline__ float fsub_s(float a,float b){float r;asm("v_sub_f32_e32 %0, %1, %2":"=v"(r):"v"(a),"v"(b));return r;}
typedef float f32x2_t __attribute__((ext_vector_type(2))); typedef __bf16 bf16x2_t __attribute__((ext_vector_type(2)));
__device__ __forceinline__ unsigned cvtpk_s(float lo,float hi){f32x2_t v={lo,hi};bf16x2_t b=__builtin_convertvector(v,bf16x2_t);return __builtin_bit_cast(unsigned,b);}
#define WAIT_BAR(N) asm volatile("s_waitcnt vmcnt(" #N ") lgkmcnt(0)\n\ts_barrier":::"memory")

__device__ __forceinline__ void qkt(f32x16&p0,f32x16&p1,const char*Kslot,const bf16x8*qr,const f32x16&negm,int r32,int hi){
  const char*kb=Kslot+hi*1024+r32*16;
  #pragma unroll
  for(int d0=0;d0<6;++d0){
    const bf16x8 b0=*reinterpret_cast<const bf16x8*>(kb+d0*2048);
    const bf16x8 b1=*reinterpret_cast<const bf16x8*>(kb+d0*2048+512);
    if(d0==0){p0=__builtin_amdgcn_mfma_f32_32x32x16_bf16(b0,qr[0],negm,0,0,0);p1=__builtin_amdgcn_mfma_f32_32x32x16_bf16(b1,qr[0],negm,0,0,0);}
    else{p0=__builtin_amdgcn_mfma_f32_32x32x16_bf16(b0,qr[d0],p0,0,0,0);p1=__builtin_amdgcn_mfma_f32_32x32x16_bf16(b1,qr[d0],p1,0,0,0);}}
}
typedef __attribute__((address_space(3))) const char* lds_cptr;
typedef short v4i16_t __attribute__((ext_vector_type(4)));
__device__ __forceinline__ void kload8(bf16x8*kf,lds_cptr kp){
  kf[0]=*(const __attribute__((address_space(3))) bf16x8*)(kp);      kf[1]=*(const __attribute__((address_space(3))) bf16x8*)(kp+512);
  kf[2]=*(const __attribute__((address_space(3))) bf16x8*)(kp+2048); kf[3]=*(const __attribute__((address_space(3))) bf16x8*)(kp+2560);
  kf[4]=*(const __attribute__((address_space(3))) bf16x8*)(kp+4096); kf[5]=*(const __attribute__((address_space(3))) bf16x8*)(kp+4608);
  kf[6]=*(const __attribute__((address_space(3))) bf16x8*)(kp+6144); kf[7]=*(const __attribute__((address_space(3))) bf16x8*)(kp+6656);
  kf[8]=*(const __attribute__((address_space(3))) bf16x8*)(kp+8192); kf[9]=*(const __attribute__((address_space(3))) bf16x8*)(kp+8704);
  kf[10]=*(const __attribute__((address_space(3))) bf16x8*)(kp+10240); kf[11]=*(const __attribute__((address_space(3))) bf16x8*)(kp+10752);
}
__device__ __forceinline__ void kload2(bf16x8*kf,lds_cptr kp,int j){ kf[2*j]=*(const __attribute__((address_space(3))) bf16x8*)(kp+j*2048); kf[2*j+1]=*(const __attribute__((address_space(3))) bf16x8*)(kp+j*2048+512); }
__device__ __forceinline__ s16x4 vtr(lds_cptr p){ return __builtin_bit_cast(s16x4,__builtin_amdgcn_ds_read_tr16_b64_v4i16((__attribute__((address_space(3))) v4i16_t*)p)); }
__device__ __forceinline__ float rowmax(const f32x16&p0,const f32x16&p1){
  float a=max3f(p0[0],p0[1],p1[0]),b=max3f(p0[2],p0[3],p1[1]);a=max3f(a,p1[2],p1[3]);
  #pragma unroll
  for(int r=4;r<16;r+=4){a=max3f(a,p0[r],p0[r+1]);b=max3f(b,p0[r+2],p0[r+3]);a=max3f(a,p1[r],p1[r+1]);b=max3f(b,p1[r+2],p1[r+3]);}
  const float m=max2f(a,b);
  auto rr=__builtin_amdgcn_permlane32_swap(__float_as_uint(m),__float_as_uint(m),false,false);
  return max2f(__uint_as_float(rr[0]),__uint_as_float(rr[1]));
}
__device__ __forceinline__ void pv(f32x16*o,int vb,bf16x8 pa0,bf16x8 pa1,bf16x8 pa2,bf16x8 pa3){
  #pragma unroll
  for(int d0=0;d0<2;++d0){s16x4 lo[4],hi[4];
    #pragma unroll
    for(int ks=0;ks<4;++ks){
      asm volatile("ds_read_b64_tr_b16 %0,%1 offset:%c2":"=&v"(lo[ks]):"v"(vb),"i"(d0*4096+ks*1024):"memory");
      asm volatile("ds_read_b64_tr_b16 %0,%1 offset:%c2":"=&v"(hi[ks]):"v"(vb),"i"(d0*4096+ks*1024+512):"memory");}
    asm volatile("s_waitcnt lgkmcnt(0)":::"memory");SBAR();
    #define PK(k) (bf16x8){lo[k][0],lo[k][1],lo[k][2],lo[k][3],hi[k][0],hi[k][1],hi[k][2],hi[k][3]}
    o[d0]=__builtin_amdgcn_mfma_f32_32x32x16_bf16(pa0,PK(0),o[d0],0,0,0);
    o[d0]=__builtin_amdgcn_mfma_f32_32x32x16_bf16(pa1,PK(1),o[d0],0,0,0);
    o[d0]=__builtin_amdgcn_mfma_f32_32x32x16_bf16(pa2,PK(2),o[d0],0,0,0);
    o[d0]=__builtin_amdgcn_mfma_f32_32x32x16_bf16(pa3,PK(3),o[d0],0,0,0);
    #undef PK
  }
}

#ifndef ATTN_STORE16
#define ATTN_STORE16(p,v) (*(u32x4*)(p)=(v))
#endif
template<int THRL> __device__ __forceinline__ void attn_unit(int b,int h,int qb,const bf16*Q,const bf16*__restrict__ K,const bf16*__restrict__ KR,const bf16*__restrict__ V,bf16*O,char*shm,int wid_s){
  const int wid=wid_s,lane=lane_now(),tid=wid*64+lane,r32=lane&31,hi=lane>>5; (void)tid;
  const long rowbase=(long)b*SEQ; const int q0=qb*QB;
  const bf16*Qw=Q+(rowbase+q0+wid*QBLK)*QPITCH+h*DQK;
  const bf16*Kh=K+rowbase*DM+h*D,*Vh=V+rowbase*DM+h*D;
  const unsigned lds0=(unsigned)(uintptr_t)shm;
  float*wsf=(float*)(shm+LDS_WS)+wid*64;
  const bf16*ksrc=Kh+(long)lane*DM+wid*8;
  const bf16*krsrc=KR+(rowbase+32*(wid&1)+(lane&31))*KRP+(wid>>1)*8;
  const bf16*vsrc=Vh+(long)(16*(wid&3)+(lane>>2))*DM+(wid>>2)*32+(lane&3)*8;
  const unsigned kdst=lds0+LDS_K+wid*1024, vdst=lds0+LDS_V+wid*1024, krdst=lds0+LDS_K+(8+(wid>>1))*1024+(wid&1)*512;
  #define DMA_K(t,slot) do{ glds16(ksrc+(long)(t)*KVBLK*DM,(unsigned)__builtin_amdgcn_readfirstlane(kdst+(slot))); if(lane<32){ glds16(krsrc+(long)(t)*KVBLK*KRP,(unsigned)__builtin_amdgcn_readfirstlane(krdst+(slot))); } }while(0)
  #define DMA_V(t,slot) glds16(vsrc+(long)(t)*KVBLK*DM,(unsigned)__builtin_amdgcn_readfirstlane(vdst+(slot)))
  const int vb0=(int)(lds0+LDS_V)+((lane>>4)&1)*32+(lane&3)*8+(4*hi+((lane&15)>>2))*64;
  const char*Kbase=shm+LDS_K; bf16x8 kf[12];
  const lds_cptr shm3=(lds_cptr)shm; const lds_cptr kp0=shm3+LDS_K+hi*1024+r32*16; const lds_cptr vp0=shm3+LDS_V+((lane>>4)&1)*32+(lane&3)*8+(4*hi+((lane&15)>>2))*64;
  const int NT=(q0+QB)/KVBLK;
  DMA_K(0,0);DMA_V(0,0);DMA_K(1,KSLOTB);
  bf16x8 qr[6];
  #pragma unroll
  for(int d0=0;d0<6;++d0)qr[d0]=*reinterpret_cast<const bf16x8*>(&Qw[(long)r32*QPITCH+d0*16+hi*8]);
  float mhat=0.f,l_reg=0.f;f32x16 o[2];o[0]=f32x16{};o[1]=f32x16{};
  const int qrel=wid*QBLK+r32;
  #define CMASK(P0,P1,t) do{int jb_=(t)-(NT-4); if(jb_>=0)cmask(P0,P1,jb_,qrel,hi);}while(0)
  bool resc=false;
  #define START(P0,P1) do{ const float rm=rowmax(P0,P1); resc=false; \
    { const float dl=rm; mhat=fadd_s(mhat,dl); \
      _Pragma("unroll") for(int r=0;r<16;++r){P0[r]=fsub_s(P0[r],dl);P1[r]=fsub_s(P1[r],dl);} \
      } \
    _Pragma("unroll") for(int r=0;r<16;++r)P0[r]=__builtin_amdgcn_exp2f(P0[r]); }while(0)
  #define RESC() do{ if(resc){ asm volatile("s_waitcnt lgkmcnt(0)":::"memory"); \
      _Pragma("unroll") for(int d_=0;d_<2;++d_) _Pragma("unroll") for(int r=0;r<16;++r)o[d_][r]*=wsf[crow(r,hi)]; } }while(0)
  f32x16 pA0,pA1,pB0,pB1;
  int sl_prev=0,sl_cur=0,sl_next=SLOTB;
  int ks_cur=0,ks_next=KSLOTB;
  #define ROT() do{sl_prev=sl_cur;sl_cur=sl_next;sl_next=(sl_next==(NSLOT-1)*SLOTB)?0:sl_next+SLOTB; ks_cur=ks_next;ks_next=(ks_next==(NSLOT-1)*KSLOTB)?0:ks_next+KSLOTB;}while(0)
  DMA_K(2,2*KSLOTB);
  WAIT_BAR(5);
  qkt(pA0,pA1,Kbase,qr,f32x16{},r32,hi);asm volatile("s_nop 15\n\ts_nop 7":"+v"(pA0),"+v"(pA1));CMASK(pA0,pA1,0);
  START(pA0,pA1);
  _Pragma("unroll") for(int r=0;r<16;++r)pA1[r]=__builtin_amdgcn_exp2f(pA1[r]);
  WAIT_BAR(0);
  DMA_K(3,0);DMA_V(1,SLOTB);
  ROT();
  kload8(kf,kp0+ks_cur);
  WAIT_BAR(3);
  s16x4 vlo[8],vhi[8]; u32x4 pw0,pw1,pw2,pw3;
  #define PKW(P,B) cvtpk_s(P[B],P[B+1])
  #define PAF(k) __builtin_bit_cast(bf16x8,pw##k)
  #define VFR(i) (bf16x8){vlo[i][0],vlo[i][1],vlo[i][2],vlo[i][3],vhi[i][0],vhi[i][1],vhi[i][2],vhi[i][3]}
  #define PIN(x) asm volatile("":"+v"(x))
  #define MX3(a,b,c) __builtin_fmaxf(__builtin_fmaxf((a),(b)),(c))
  #define GAPA(MF,A0,A1,A2,A3,W0,W1,PW) do{ MF; sacc+=A0; sacc+=A1; sacc+=A2; sacc+=A3; PIN(sacc); W0; W1; PIN(PW); SBAR(); }while(0)
  #define EX(v) __builtin_amdgcn_exp2f(v)
  #define GAPB(MF,X,B) do{ MF; X[B]=EX(X[B]); X[B+1]=EX(X[B+1]); X[B+2]=EX(X[B+2]); X[B+3]=EX(X[B+3]); PIN(X); SBAR(); }while(0)
  #define VRD(i) do{ vlo[i]=vtr(vp_+(((i)>>2)*4096+((i)&3)*1024)); vhi[i]=vtr(vp_+(((i)>>2)*4096+((i)&3)*1024+512)); }while(0)
  #define KRD(G,j) do{ if(G){ kload2(kf,kp0+ks_next,j); SBAR(); } }while(0)
  #define NEGM() splat16(-mhat)
  #define STEP(C0,C1,P0,P1,t,GK,GV,GL) do{ SBAR(); \
    const lds_cptr vp_=vp0+sl_prev; \
    float sacc=(P0[0]+P0[1]); \
    GAPA(C0=__builtin_amdgcn_mfma_f32_32x32x16_bf16(kf[0],qr[0],NEGM(),0,0,0), P0[2],P0[3],P0[4],P0[5],     pw0[0]=PKW(P0,0), pw0[1]=PKW(P0,2), pw0); \
    GAPA(C1=__builtin_amdgcn_mfma_f32_32x32x16_bf16(kf[1],qr[0],NEGM(),0,0,0), P0[6],P0[7],P0[8],P0[9],     pw0[2]=PKW(P0,4), pw0[3]=PKW(P0,6), pw0); \
    GAPA(C0=__builtin_amdgcn_mfma_f32_32x32x16_bf16(kf[2],qr[1],C0,0,0,0),   P0[10],P0[11],P0[12],P0[13], pw1[0]=PKW(P0,8), pw1[1]=PKW(P0,10), pw1); \
    GAPA(C1=__builtin_amdgcn_mfma_f32_32x32x16_bf16(kf[3],qr[1],C1,0,0,0),   P0[14],P0[15],P1[0],P1[1],   pw1[2]=PKW(P0,12),pw1[3]=PKW(P0,14), pw1); \
    VRD(0); SBAR(); GAPA(C0=__builtin_amdgcn_mfma_f32_32x32x16_bf16(kf[4],qr[2],C0,0,0,0),   P1[2],P1[3],P1[4],P1[5],     pw2[0]=PKW(P1,0), pw2[1]=PKW(P1,2), pw2); \
    VRD(4); SBAR(); GAPA(C1=__builtin_amdgcn_mfma_f32_32x32x16_bf16(kf[5],qr[2],C1,0,0,0),   P1[6],P1[7],P1[8],P1[9],     pw2[2]=PKW(P1,4), pw2[3]=PKW(P1,6), pw2); \
    VRD(1); SBAR(); GAPA(C0=__builtin_amdgcn_mfma_f32_32x32x16_bf16(kf[6],qr[3],C0,0,0,0),   P1[10],P1[11],P1[12],P1[13], pw3[0]=PKW(P1,8), pw3[1]=PKW(P1,10), pw3); \
    VRD(5); SBAR(); GAPA(C1=__builtin_amdgcn_mfma_f32_32x32x16_bf16(kf[7],qr[3],C1,0,0,0),   P1[14],P1[15],0.f,0.f,       pw3[2]=PKW(P1,12),pw3[3]=PKW(P1,14), pw3); \
    VRD(2); SBAR(); C0=__builtin_amdgcn_mfma_f32_32x32x16_bf16(kf[8],qr[4],C0,0,0,0); SBAR(); \
    VRD(6); SBAR(); C1=__builtin_amdgcn_mfma_f32_32x32x16_bf16(kf[9],qr[4],C1,0,0,0); SBAR(); \
    VRD(3); SBAR(); C0=__builtin_amdgcn_mfma_f32_32x32x16_bf16(kf[10],qr[5],C0,0,0,0); SBAR(); \
    VRD(7); SBAR(); C1=__builtin_amdgcn_mfma_f32_32x32x16_bf16(kf[11],qr[5],C1,0,0,0); SBAR(); \
    l_reg+=sacc; \
    if(GK){DMA_K((t)+3,ks_cur);} if(GV){DMA_V((t)+1,sl_next);} \
    CMASK(C0,C1,t); \
    { float a=MX3(C0[0],C0[1],C1[0]),b=MX3(C0[2],C0[3],C1[1]); a=MX3(a,C1[2],C1[3]); \
      _Pragma("unroll") for(int r=4;r<16;r+=4){a=MX3(a,C0[r],C0[r+1]);b=MX3(b,C0[r+2],C0[r+3]);a=MX3(a,C1[r],C1[r+1]);b=MX3(b,C1[r+2],C1[r+3]);} \
      float rm=__builtin_fmaxf(a,b); { auto rr=__builtin_amdgcn_permlane32_swap(__float_as_uint(rm),__float_as_uint(rm),false,false); rm=__builtin_fmaxf(__uint_as_float(rr[0]),__uint_as_float(rr[1])); } \
      resc=false; \
      if(__builtin_expect(__any(rm>(float)THRL),0)){ const float dl=__builtin_fmaxf(rm,0.f); mhat+=dl; \
        _Pragma("unroll") for(int r=0;r<16;++r){C0[r]-=dl;C1[r]-=dl;} \
        const float f=__builtin_amdgcn_exp2f(-dl); l_reg*=f; if(hi==0){ int r32o_=r32; asm volatile("":"+v"(r32o_)); wsf[r32o_]=f; } resc=true; } } \
    SBAR(); \
    GAPB(o[0]=__builtin_amdgcn_mfma_f32_32x32x16_bf16(PAF(0),VFR(0),o[0],0,0,0), C0,0); \
    KRD(GL,0); GAPB(o[1]=__builtin_amdgcn_mfma_f32_32x32x16_bf16(PAF(0),VFR(4),o[1],0,0,0), C0,4); \
    KRD(GL,1); GAPB(o[0]=__builtin_amdgcn_mfma_f32_32x32x16_bf16(PAF(1),VFR(1),o[0],0,0,0), C0,8); \
    KRD(GL,2); GAPB(o[1]=__builtin_amdgcn_mfma_f32_32x32x16_bf16(PAF(1),VFR(5),o[1],0,0,0), C0,12); \
    KRD(GL,3); GAPB(o[0]=__builtin_amdgcn_mfma_f32_32x32x16_bf16(PAF(2),VFR(2),o[0],0,0,0), C1,0); \
    KRD(GL,4); GAPB(o[1]=__builtin_amdgcn_mfma_f32_32x32x16_bf16(PAF(2),VFR(6),o[1],0,0,0), C1,4); \
    KRD(GL,5); GAPB(o[0]=__builtin_amdgcn_mfma_f32_32x32x16_bf16(PAF(3),VFR(3),o[0],0,0,0), C1,8); \
    GAPB(o[1]=__builtin_amdgcn_mfma_f32_32x32x16_bf16(PAF(3),VFR(7),o[1],0,0,0), C1,12); \
    }while(0)
  int t=1;
  #undef CMASK
  #define CMASK(P0,P1,t) do{}while(0)
  for(;t+5<NT;t+=2){
    STEP(pB0,pB1,pA0,pA1,t,true,true,true);     WAIT_BAR(3); RESC(); ROT();
    STEP(pA0,pA1,pB0,pB1,t+1,true,true,true);   WAIT_BAR(3); RESC(); ROT();
  }
  #undef CMASK
  #define CMASK(P0,P1,t) do{int jb_=(t)-(NT-4); if(jb_>=0)cmask(P0,P1,jb_,qrel,hi);}while(0)
  #define ENDW(tt) do{ if((tt)+3<NT){WAIT_BAR(3);} else if((tt)+2<NT){WAIT_BAR(1);} else {WAIT_BAR(0);} }while(0)
  for(;t+1<NT;t+=2){
    STEP(pB0,pB1,pA0,pA1,t,(t+3<NT),(t+1<NT),(t+1<NT));       ENDW(t);   RESC(); ROT();
    STEP(pA0,pA1,pB0,pB1,t+1,(t+4<NT),(t+2<NT),(t+2<NT));     ENDW(t+1); RESC(); ROT();
  }
  STEP(pB0,pB1,pA0,pA1,NT-1,false,false,false); RESC();
  { float sacc=pB0[0]+pB0[1]; _Pragma("unroll") for(int r=2;r<16;++r)sacc+=pB0[r]; _Pragma("unroll") for(int r=0;r<16;++r)sacc+=pB1[r]; l_reg+=sacc;
    pw0=(u32x4){PKW(pB0,0),PKW(pB0,2),PKW(pB0,4),PKW(pB0,6)};pw1=(u32x4){PKW(pB0,8),PKW(pB0,10),PKW(pB0,12),PKW(pB0,14)};pw2=(u32x4){PKW(pB1,0),PKW(pB1,2),PKW(pB1,4),PKW(pB1,6)};pw3=(u32x4){PKW(pB1,8),PKW(pB1,10),PKW(pB1,12),PKW(pB1,14)};
    SBAR(); pv(o,vb0+sl_cur,PAF(0),PAF(1),PAF(2),PAF(3)); }
  #undef PKW
  #undef PAF
  #undef VFR
  #undef PIN
  #undef MX3
  #undef GAPA
  #undef GAPB
  #undef EX
  #undef VRD
  #undef KRD
  #undef STEP
  #undef ENDW
  {auto rr=__builtin_amdgcn_permlane32_swap(__float_as_uint(l_reg),__float_as_uint(l_reg),false,false);l_reg=__uint_as_float(rr[0])+__uint_as_float(rr[1]);}
  if(hi==0)wsf[32+r32]=l_reg;asm volatile("s_waitcnt lgkmcnt(0)":::"memory");
  float rli[16];
  #pragma unroll
  for(int r=0;r<16;++r)rli[r]=__builtin_amdgcn_rcpf(wsf[32+crow(r,hi)]);
  bf16*Ow=O+(rowbase+q0+wid*QBLK)*DM+h*D;
  { bf16*stg=(bf16*)(shm+LDS_OST)+wid*2048;
    #pragma unroll
    for(int r=0;r<16;++r){const int orow=crow(r,hi);
      #pragma unroll
      for(int d0=0;d0<2;++d0)stg[orow*64+d0*32+r32]=__float2bfloat16(o[d0][r]*rli[r]);}
    asm volatile("s_waitcnt lgkmcnt(0)":::"memory");
    #pragma unroll
    for(int i=0;i<4;++i){const int row=i*8+(lane>>3),ch=lane&7; const u32x4 v=*(const u32x4*)(stg+row*64+ch*8); ATTN_STORE16(Ow+(long)row*DM+ch*8,v);} }
  asm volatile("s_waitcnt lgkmcnt(0)\n\ts_barrier":::"memory");
  #undef DMA_K
  #undef DMA_V
  #undef CMASK
  #undef START
  #undef RESC
  #undef ROT
}
constexpr int ATTN_LDS_BYTES=LDS_BYTES;
struct AttnTensors { const bf16* Q; const bf16* K; const bf16* KR; const bf16* V; bf16* O; };
struct AttnUnit { int bh; int qb; };
struct StaticOrder {
  int vcu;
  __device__ __forceinline__ explicit StaticOrder(int grid,int block):vcu((block%8)*(grid/8)+block/8){}
  __device__ __forceinline__ bool next(int i,AttnUnit&u)const{ if(i>=2)return false; const int s=vcu&15; u.bh=vcu>>4; u.qb=(i==0)?s:31-s; return true; }
  __device__ __forceinline__ void a_ready(const AttnUnit&)const{}
  __device__ __forceinline__ void done(const AttnUnit&)const{}
};
template<class Sched,int THRL=8> __device__ __forceinline__ void attn_phase(char*lds,const AttnTensors&T,const Sched&S,int wid_s){
  AttnUnit u;
  for(int i=0;S.next(i,u);++i){ S.a_ready(u); attn_unit<THRL>(u.bh/NHEAD,u.bh%NHEAD,u.qb,T.Q,T.K,T.KR,T.V,T.O,lds,wid_s); S.done(u); }
}
#undef SBAR
#undef WAIT_BAR
}
#define GAS __attribute__((address_space(1)))
#define LAS __attribute__((address_space(3)))
typedef unsigned short bf16;
typedef unsigned v4u __attribute__((ext_vector_type(4)));
typedef float f32x4 __attribute__((ext_vector_type(4)));
typedef short bf16x8 __attribute__((ext_vector_type(8)));
typedef GAS unsigned gu32;
typedef GAS unsigned long long gu64;
#define RLX_AGENT __ATOMIC_RELAXED, __HIP_MEMORY_SCOPE_AGENT
#define LDS_WAIT() asm volatile("s_waitcnt lgkmcnt(0)" ::: "memory")
#define VM_WAIT() asm volatile("s_waitcnt vmcnt(0)" ::: "memory")
__device__ __forceinline__ unsigned long long rt() { return __builtin_amdgcn_s_memrealtime(); }
__device__ __forceinline__ unsigned f2bf(float f) { unsigned u = __builtin_bit_cast(unsigned, f); return (u + 0x7fffu + ((u >> 16) & 1u)) >> 16; }
__device__ __forceinline__ unsigned pk2(float lo, float hi) { return f2bf(lo) | (f2bf(hi) << 16); }

#define XB_TMO      128
#define XB_XCNT(j)  (256  + 64 * (j))
#define XB_XSUB(j)  (1280 + 64 * (j))
#define XB_XGEN(j)  (2304 + 64 * (j))
#define XB_TOP      3328
#define XB_TOPGEN   3392
#define XCD_BAR_WORDS 3456
#define XB_SPIN_CAP (1u << 18)

__device__ __forceinline__ unsigned xb_ld(unsigned* p)              { return __hip_atomic_load(p, __ATOMIC_RELAXED, __HIP_MEMORY_SCOPE_AGENT); }
__device__ __forceinline__ unsigned xb_add(unsigned* p, unsigned v) { return __hip_atomic_fetch_add(p, v, __ATOMIC_RELAXED, __HIP_MEMORY_SCOPE_AGENT); }
__device__ __forceinline__ unsigned xb_xcc_id() { return (unsigned)__builtin_amdgcn_s_getreg((3 << 11) | 20) & 0xFu; }
#define XB_SPIN(cond, bar) do { unsigned _sp = 0; while (cond) { __builtin_amdgcn_s_sleep(1); \
    if ((++_sp & 255u) == 0u) { if (xb_ld(&(bar)[XB_TMO])) break; if (_sp > XB_SPIN_CAP) { atomicAdd(&(bar)[XB_TMO], 1u); break; } } } } while (0)

struct XcdBarrier {
    unsigned* bar; unsigned x;
    volatile LAS unsigned* st;
};

__device__ __forceinline__ XcdBarrier xcd_barrier_post(unsigned* bar, volatile LAS unsigned* st, bool t0  ) {
    XcdBarrier b; b.bar = bar; b.x = xb_xcc_id(); b.st = st;
    if (t0) (void)xb_add(&bar[XB_XCNT(b.x)], 1u);
    return b;
}
__device__ __forceinline__ void xcd_barrier_complete(unsigned* bar, unsigned x, unsigned& nloc, unsigned& nx) {
    const unsigned G = gridDim.x * gridDim.y * gridDim.z;
    unsigned sum, cnt, mine, sp = 0u;
    for (;;) {
        sum = 0u; cnt = 0u; mine = 0u;
#pragma unroll
        for (unsigned j = 0; j < 16; ++j) { const unsigned c = xb_ld(&bar[XB_XCNT(j)]); sum += c; cnt += (c > 0u) ? 1u : 0u; mine = (j == x) ? c : mine; }
        if (sum == G) break;
        __builtin_amdgcn_s_sleep(1);
        if ((++sp & 255u) == 0u) { if (xb_ld(&bar[XB_TMO])) break; if (sp > XB_SPIN_CAP) { atomicAdd(&bar[XB_TMO], 1u); break; } }
    }
    nloc = mine > 0u ? mine : 1u; nx = cnt > 0u ? cnt : 1u;
}

__device__ __forceinline__ void xcd_barrier(const XcdBarrier& b, bool t0  ) {
    asm volatile("s_waitcnt vmcnt(0)" ::: "memory");
    __syncthreads();
    if (t0) {
        unsigned* bar = b.bar;
        __builtin_amdgcn_s_waitcnt(0);
        unsigned nloc = b.st[0], nx = b.st[1];
        if (nloc == 0u) { xcd_barrier_complete(bar, b.x, nloc, nx); b.st[0] = nloc; b.st[1] = nx; }
        const unsigned old = xb_add(&bar[XB_XSUB(b.x)], 1u);
        const unsigned gen = old / nloc;
        if (old + 1u == (gen + 1u) * nloc) {
            __builtin_amdgcn_fence(__ATOMIC_RELEASE, "agent");
            asm volatile("s_waitcnt vmcnt(0)" ::: "memory");
            const unsigned og = xb_add(&bar[XB_TOP], 1u);
            const unsigned tg = og / nx;
            if (og + 1u == (tg + 1u) * nx) xb_add(&bar[XB_TOPGEN], 1u);
            else XB_SPIN(xb_ld(&bar[XB_TOPGEN]) == tg, bar);
            __builtin_amdgcn_fence(__ATOMIC_ACQUIRE, "agent");
            xb_add(&bar[XB_XGEN(b.x)], 1u);
            asm volatile("s_waitcnt vmcnt(0)" ::: "memory");
        } else {
            XB_SPIN(xb_ld(&bar[XB_XGEN(b.x)]) == gen, bar);
            __builtin_amdgcn_fence(__ATOMIC_ACQUIRE, "agent");
            asm volatile("s_waitcnt vmcnt(0)" ::: "memory");
        }
    }
    __syncthreads();
}
constexpr int NWAVES = 8;
#ifndef MK_N_LAUNCHES
#define MK_N_LAUNCHES 1
#endif
constexpr int N_PHASES = 11;

constexpr int MP = 16384, MS = 1024, MT = MP + MS;
constexpr int DM = 1024, NZ = 1792, QRK = 384, NQ = 768, FFN = 2816, NGU = 2 * FFN;
constexpr int NPOS = 8200;
constexpr float EPSN = 1e-6f;
constexpr int Z_KR = 384, Z_CKV = 512, Z_U = 768, Z_V = 1280;
constexpr float QSCALE = 0.10206207261596575f * 1.4426950408889634f;
constexpr size_t O_Y = 0, O_CKVP = (size_t)MT * DM, O_KRP = O_CKVP + (size_t)MP * 256, O_CKVS = O_KRP + (size_t)MP * 32, O_KRS = O_CKVS + (size_t)MS * 256, O_VS = O_KRS + (size_t)MS * 32, O_END = O_VS + (size_t)MS * 512;

constexpr size_t MiB = 1u << 20;
constexpr size_t WS_CTL = 0, CTL_ZERO_BYTES = 1 * MiB;
constexpr size_t WS_ROPE = 1 * MiB;
constexpr size_t WS_WIN = 3 * MiB;
constexpr size_t WS_WQUP = 7 * MiB;
constexpr size_t WS_WKV = 8 * MiB;
constexpr size_t WS_WUKB = 9 * MiB;
constexpr size_t WS_WSB = 10 * MiB;
constexpr size_t WS_WOUT = 11 * MiB;
constexpr size_t WS_WGU = 13 * MiB;
constexpr size_t WS_WDN = 24 * MiB;
constexpr size_t WS_XN = 30 * MiB;
constexpr size_t WS_Z = 64 * MiB;
constexpr size_t WS_CQN = 124 * MiB;
constexpr size_t WS_CKVB = 137 * MiB;
constexpr size_t WS_KRB = 146 * MiB;
constexpr size_t WS_U = 148 * MiB;
constexpr size_t WS_VB = 165 * MiB;
constexpr size_t WS_Q = 182 * MiB;
constexpr size_t WS_KN = 208 * MiB;
constexpr size_t WS_VH = 224 * MiB;
constexpr size_t WS_QLAT = 240 * MiB;
constexpr size_t WS_ATT = 245 * MiB;
constexpr size_t WS_OPART = 262 * MiB;
constexpr size_t WS_ML = 278 * MiB;
constexpr size_t WS_MG = 279 * MiB;
constexpr size_t WS_X1 = 313 * MiB;
constexpr size_t WS_XN2 = 381 * MiB;
constexpr size_t WS_H = 415 * MiB;
constexpr size_t WS_END = 509 * MiB;
static_assert(WS_XN + (size_t)MT * 1024 * 2 <= WS_Z && WS_Z + (size_t)MT * NZ * 2 <= WS_CQN && WS_CQN + (size_t)MT * 384 * 2 <= WS_CKVB && WS_CKVB + (size_t)MT * 256 * 2 <= WS_KRB && WS_KRB + (size_t)MT * 32 * 2 <= WS_U, "ws map 1");
static_assert(WS_U + (size_t)MT * 512 * 2 <= WS_VB && WS_VB + (size_t)MT * 512 * 2 <= WS_Q && WS_Q + (size_t)MT * 768 * 2 <= WS_KN && WS_KN + (size_t)MP * 512 * 2 <= WS_VH && WS_VH + (size_t)MP * 512 * 2 <= WS_QLAT, "ws map 2");
static_assert(WS_QLAT + (size_t)MS * 8 * 288 * 2 <= WS_ATT && WS_ATT + (size_t)MT * 512 * 2 <= WS_OPART && WS_OPART + (size_t)128 * 2 * 64 * 256 * 4 <= WS_ML && WS_ML + 128 * 2 * 64 * 2 * 4 <= WS_MG, "ws map 3");
static_assert(WS_MG + (size_t)MT * 1024 * 2 <= WS_X1 && WS_X1 + (size_t)MT * 1024 * 4 <= WS_XN2 && WS_XN2 + (size_t)MT * 1024 * 2 <= WS_H && WS_H + (size_t)MT * FFN * 2 <= WS_END, "ws map 4");
static_assert(WS_WIN + (size_t)NZ * 1024 * 2 <= WS_WQUP && WS_WGU + (size_t)NGU * 1024 * 2 <= WS_WDN && WS_WDN + (size_t)1024 * FFN * 2 <= WS_XN && WS_ROPE + (size_t)NPOS * 32 * 4 <= WS_WIN, "ws map 0");
constexpr int CW_TMO = 0, CW_CODE = 1;
constexpr int CW_BAR = 4096;

constexpr int RING_OFF = 0, RING_BYTES = 131072;
constexpr int LDS_BYTES = 147456;
constexpr int MISC_OFF = LDS_BYTES - 256;
constexpr int LDS_X = 131072;

struct Args { const float* in[24]; float* out; unsigned char* ws; int ph_lo, ph_hi; };
struct Ctx { LAS unsigned char* lds; int tid, lane, wave, vcu, G; };
typedef const __attribute__((address_space(4))) Args* kargs_t;
#define KARGS() ({ kargs_t p_ = (kargs_t)__builtin_amdgcn_kernarg_segment_ptr(); asm volatile("" : "+s"(p_)); p_; })

__device__ __forceinline__ float wave_sum(float v) {
#pragma unroll
    for (int o = 1; o < 64; o <<= 1) v += __shfl_xor(v, o);
    return v;
}
__device__ __forceinline__ float bf2f(unsigned short h) { return __builtin_bit_cast(float, (unsigned)h << 16); }
__device__ __forceinline__ float bflo(unsigned w) { return __builtin_bit_cast(float, w << 16); }
__device__ __forceinline__ float bfhi(unsigned w) { return __builtin_bit_cast(float, w & 0xffff0000u); }
#define LBAR() do { asm volatile("s_waitcnt lgkmcnt(0)" ::: "memory"); __builtin_amdgcn_s_barrier(); asm volatile("" ::: "memory"); } while (0)

__device__ __forceinline__ int drow_map(int mat, int c) {
    switch (mat) {
    case 0: if (c < 384) return c; if (c < 640) return Z_CKV + (c - 384); if (c < 672) return Z_KR + (c - 640); if (c < 1184) return Z_U + (c - 672); return Z_V + (c - 1184);
    case 1: { const int h = c / 96, i = c % 96; if (i < 64) return c; const int r = i - 64; return 96 * h + 64 + ((r < 16) ? 2 * r : 2 * (r - 16) + 1); }
    case 3: return 512 + c;
    case 5: return 256 * (c >> 7) + (c & 127);
    case 6: return 256 * (c >> 7) + 128 + (c & 127);
    default: return c;
    }
}
__device__ __forceinline__ void p0_transpose_item(const float* W, int K, int ldw, bf16* WT, const float* gk, int mat, LAS float* scr, int kb, int nb, int lane) {
    const int k0 = 64 * kb, n0 = 32 * nb;
#pragma unroll 8
    for (int i = 0; i < 32; ++i) { const int kk = 2 * i + (lane >> 5); float w = W[(size_t)(k0 + kk) * ldw + n0 + (lane & 31)]; if (gk) w *= gk[k0 + kk]; scr[kk * 33 + (lane & 31)] = w; }
    LDS_WAIT(); asm volatile("" ::: "memory");
    const int c = lane & 7;
#pragma unroll
    for (int j = 0; j < 4; ++j) { const int n = (lane >> 3) + 8 * j; const LAS float* s = scr + (8 * c) * 33 + n;
        v4u o; o.x = pk2(s[0 * 33], s[1 * 33]); o.y = pk2(s[2 * 33], s[3 * 33]); o.z = pk2(s[4 * 33], s[5 * 33]); o.w = pk2(s[6 * 33], s[7 * 33]);
        *(GAS v4u*)(WT + (size_t)drow_map(mat, n0 + n) * K + k0 + 8 * c) = o; }
    LDS_WAIT(); asm volatile("" ::: "memory");
}
__device__ __forceinline__ void rms_row_to_bf16(const float* xrow, bf16* orow, int lane) {
    const GAS f32x4* xr = (const GAS f32x4*)xrow + lane;
    f32x4 v[4]; float s = 0.f;
#pragma unroll
    for (int j = 0; j < 4; ++j) { v[j] = xr[64 * j]; s += (v[j].x * v[j].x + v[j].y * v[j].y) + (v[j].z * v[j].z + v[j].w * v[j].w); }
    const float rstd = 1.f / sqrtf(wave_sum(s) * (1.f / 1024.f) + EPSN);
    GAS unsigned long long* o8 = (GAS unsigned long long*)orow + lane;
#pragma unroll
    for (int j = 0; j < 4; ++j) o8[64 * j] = (unsigned long long)pk2(v[j].x * rstd, v[j].y * rstd) | ((unsigned long long)pk2(v[j].z * rstd, v[j].w * rstd) << 32);
}
__device__ __forceinline__ float rope_inv(int j) {
    switch (j) { case 0: return 1.0f; case 1: return 0.5623413324356079f; case 2: return 0.3162277638912201f; case 3: return 0.17782793939113617f; case 4: return 0.10000000149011612f;
    case 5: return 0.05623413249850273f; case 6: return 0.03162277489900589f; case 7: return 0.017782794311642647f; case 8: return 0.009999999776482582f; case 9: return 0.005623413249850273f;
    case 10: return 0.003162277629598975f; case 11: return 0.0017782794311642647f; case 12: return 0.0010000000474974513f; case 13: return 0.000562341301701963f; case 14: return 0.0003162277571391314f;
    default: return 0.00017782794020604342f; }
}
__device__ __forceinline__ void sincos_d(double a, double& cs, double& sn) {
    const double k = __builtin_rint(a * 0.63661977236758134308);
    double y = __builtin_fma(-k, 1.57079632679489655800e+00, a); y = __builtin_fma(-k, 6.12323399573676603587e-17, y);
    const double y2 = y * y;
    double sp = -1.0 / 1307674368000.0; sp = sp * y2 + 1.0 / 6227020800.0; sp = sp * y2 - 1.0 / 39916800.0; sp = sp * y2 + 1.0 / 362880.0; sp = sp * y2 - 1.0 / 5040.0; sp = sp * y2 + 1.0 / 120.0; sp = sp * y2 - 1.0 / 6.0; sp = sp * y2 + 1.0;
    const double s0 = y * sp;
    double cp = 1.0 / 20922789888000.0; cp = cp * y2 - 1.0 / 87178291200.0; cp = cp * y2 + 1.0 / 479001600.0; cp = cp * y2 - 1.0 / 3628800.0; cp = cp * y2 + 1.0 / 40320.0; cp = cp * y2 - 1.0 / 720.0; cp = cp * y2 + 1.0 / 24.0; cp = cp * y2 - 0.5; cp = cp * y2 + 1.0;
    const int q = ((int)k) & 3;
    cs = (q == 0) ? cp : (q == 1) ? -s0 : (q == 2) ? -cp : s0;
    sn = (q == 0) ? s0 : (q == 1) ? cp : (q == 2) ? -s0 : -cp;
}
__device__ __forceinline__ void p0_prologue(kargs_t A, const Ctx& C) {
    unsigned char* ws = A->ws;
    LAS float* scr = (LAS float*)(C.lds + RING_OFF + C.wave * 16384);
    const int gw = C.vcu * NWAVES + C.wave, NGW = C.G * NWAVES;
    constexpr int NITEMS = 5856;
    for (int it = gw; it < NITEMS; it += NGW) {
        int mat, r;
        if (it < 848) { mat = 0; r = it; } else if (it < 992) { mat = 1; r = it - 848; } else if (it < 1056) { mat = 2; r = it - 992; } else if (it < 1120) { mat = 3; r = it - 1056; }
        else if (it < 1632) { mat = 4; r = it - 1120; } else if (it < 3040) { mat = 5; r = it - 1632; } else if (it < 4448) { mat = 6; r = it - 3040; } else { mat = 7; r = it - 4448; }
        const float* W; int K, ldw; bf16* WT; const float* gk = nullptr;
        switch (mat) {
        case 0: W = A->in[6]; K = 1024; ldw = 1696; WT = (bf16*)(ws + WS_WIN); gk = A->in[5]; break;
        case 1: W = A->in[8]; K = 384; ldw = 768; WT = (bf16*)(ws + WS_WQUP); gk = A->in[7]; break;
        case 2: W = A->in[10]; K = 256; ldw = 512; WT = (bf16*)(ws + WS_WKV); break;
        case 3: W = A->in[11]; K = 256; ldw = 512; WT = (bf16*)(ws + WS_WKV); break;
        case 4: W = A->in[18]; K = 1024; ldw = 1024; WT = (bf16*)(ws + WS_WOUT); break;
        case 5: W = A->in[20]; K = 1024; ldw = 2816; WT = (bf16*)(ws + WS_WGU); gk = A->in[19]; break;
        case 6: W = A->in[21]; K = 1024; ldw = 2816; WT = (bf16*)(ws + WS_WGU); gk = A->in[19]; break;
        default: W = A->in[22]; K = 2816; ldw = 1024; WT = (bf16*)(ws + WS_WDN); break;
        }
        const int nblk = ldw / 32, kb = r / nblk, nb = r % nblk;
        if (mat == 4) gk = (kb < 8) ? A->in[16] : (A->in[17] - 512);
        p0_transpose_item(W, K, ldw, WT, gk, mat, scr, kb, nb, C.lane);
    }
    const int gt = C.vcu * (NWAVES * 64) + C.tid, NGT = C.G * NWAVES * 64;
    {
        const float* w = A->in[10]; bf16* d = (bf16*)(ws + WS_WUKB);
        for (int i = gt; i < 16384; i += NGT) { const f32x4 a = *(const f32x4*)(w + 8 * (size_t)i), b = *(const f32x4*)(w + 8 * (size_t)i + 4);
            v4u o; o.x = pk2(a.x, a.y); o.y = pk2(a.z, a.w); o.z = pk2(b.x, b.y); o.w = pk2(b.z, b.w); *(v4u*)(d + 8 * (size_t)i) = o; }
    }
    {
        const float* w = A->in[14]; bf16* d = (bf16*)(ws + WS_WSB);
        for (int i = gt; i < 16384; i += NGT) { const int e = 8 * i, ii = (e >> 7) & 127, j0 = e & 127;
            const f32x4 a = *(const f32x4*)(w + e), b = *(const f32x4*)(w + e + 4); float t[8] = {a.x, a.y, a.z, a.w, b.x, b.y, b.z, b.w};
#pragma unroll
            for (int k = 0; k < 8; ++k) if (j0 + k > ii) t[k] = 0.f;
            v4u o; o.x = pk2(t[0], t[1]); o.y = pk2(t[2], t[3]); o.z = pk2(t[4], t[5]); o.w = pk2(t[6], t[7]); *(v4u*)(d + e) = o; }
    }
    {
        bf16* d = (bf16*)(ws + WS_WIN) + (size_t)416 * 1024;
        for (int i = gt; i < 12288; i += NGT) *(v4u*)(d + 8 * (size_t)i) = (v4u){0u, 0u, 0u, 0u};
    }
    {
        float* d = (float*)(ws + WS_ROPE);
        for (int i = gt; i < NPOS * 16; i += NGT) { const int pos = i >> 4, j = i & 15;
            const float ang = (float)pos * rope_inv(j); double cs, sn; sincos_d((double)ang, cs, sn);
            d[2 * i] = (float)cs; d[2 * i + 1] = (float)sn; }
    }
    for (int m = gw; m < MT; m += NGW) {
        const float* xr = (m < MP) ? (A->in[0] + (size_t)m * DM) : (A->in[1] + (size_t)(m - MP) * DM);
        rms_row_to_bf16(xr, (bf16*)(ws + WS_XN) + (size_t)m * DM, C.lane);
    }
}

__device__ __forceinline__ float gelu_erf(float v) { return 0.5f * v * (1.0f + erff(v * 0.70710678118654752f)); }
__device__ __forceinline__ void p2_post(kargs_t A, const Ctx& C) {
    unsigned char* ws = A->ws; const int lane = C.lane;
    const int gw = C.vcu * NWAVES + C.wave, NGW = C.G * NWAVES;
    const bf16* Z = (const bf16*)(ws + WS_Z);
    const float* rope = (const float*)(ws + WS_ROPE);
    const f32x4 gkv = *(const f32x4*)(A->in[9] + 4 * lane);
    const f32x4 gv0 = *(const f32x4*)(A->in[12] + 8 * lane), gv1 = *(const f32x4*)(A->in[12] + 8 * lane + 4);
    const f32x4 bv0 = *(const f32x4*)(A->in[13] + 8 * lane), bv1 = *(const f32x4*)(A->in[13] + 8 * lane + 4);
    for (int m = gw; m < MT; m += NGW) {
        const bf16* zr = Z + (size_t)m * NZ;
        v4u wq = (v4u){0u, 0u, 0u, 0u}; if (lane < 48) wq = *(const v4u*)(zr + 8 * lane);
        const unsigned long long wk = *(const unsigned long long*)(zr + Z_CKV + 4 * lane);
        const v4u wu = *(const v4u*)(zr + Z_U + 8 * lane), wv = *(const v4u*)(zr + Z_V + 8 * lane);
        float x1 = 0.f, x2 = 0.f; if (lane < 16) { x1 = bf2f(zr[Z_KR + lane]); x2 = bf2f(zr[Z_KR + 16 + lane]); }
        float cq[8] = {bflo(wq.x), bfhi(wq.x), bflo(wq.y), bfhi(wq.y), bflo(wq.z), bfhi(wq.z), bflo(wq.w), bfhi(wq.w)};
        float ck[4] = {bflo((unsigned)wk), bfhi((unsigned)wk), bflo((unsigned)(wk >> 32)), bfhi((unsigned)(wk >> 32))};
        float uu[8] = {bflo(wu.x), bfhi(wu.x), bflo(wu.y), bfhi(wu.y), bflo(wu.z), bfhi(wu.z), bflo(wu.w), bfhi(wu.w)};
        float vv[8] = {bflo(wv.x), bfhi(wv.x), bflo(wv.y), bfhi(wv.y), bflo(wv.z), bfhi(wv.z), bflo(wv.w), bfhi(wv.w)};
        float sq = 0.f, sk = 0.f, sv = 0.f;
#pragma unroll
        for (int k = 0; k < 8; ++k) { sq += cq[k] * cq[k]; uu[k] = gelu_erf(uu[k]); vv[k] = gelu_erf(vv[k]); sv += vv[k]; }
#pragma unroll
        for (int k = 0; k < 4; ++k) sk += ck[k] * ck[k];
#pragma unroll
        for (int o = 1; o < 64; o <<= 1) { sq += __shfl_xor(sq, o); sk += __shfl_xor(sk, o); sv += __shfl_xor(sv, o); }
        const float mean = sv * (1.f / 512.f); float s2 = 0.f;
#pragma unroll
        for (int k = 0; k < 8; ++k) { vv[k] -= mean; s2 += vv[k] * vv[k]; }
        s2 = wave_sum(s2);
        const float rq = 1.f / sqrtf(sq * (1.f / 384.f) + EPSN), rk = 1.f / sqrtf(sk * (1.f / 256.f) + EPSN), rv = 1.f / sqrtf(s2 * (1.f / 512.f) + EPSN);
        if (lane < 48) { v4u o; o.x = pk2(cq[0] * rq, cq[1] * rq); o.y = pk2(cq[2] * rq, cq[3] * rq); o.z = pk2(cq[4] * rq, cq[5] * rq); o.w = pk2(cq[6] * rq, cq[7] * rq);
            *(v4u*)((bf16*)(ws + WS_CQN) + (size_t)m * QRK + 8 * lane) = o; }
        { f32x4 o; o.x = ck[0] * rk * gkv.x; o.y = ck[1] * rk * gkv.y; o.z = ck[2] * rk * gkv.z; o.w = ck[3] * rk * gkv.w;
          float* dst = (m < MP) ? (A->out + O_CKVP + (size_t)m * 256) : (A->out + O_CKVS + (size_t)(m - MP) * 256);
          *(f32x4*)(dst + 4 * lane) = o;
          *(unsigned long long*)((bf16*)(ws + WS_CKVB) + (size_t)m * 256 + 4 * lane) = (unsigned long long)pk2(o.x, o.y) | ((unsigned long long)pk2(o.z, o.w) << 32); }
        if (lane < 16) { const int pos = (m < MP) ? (m & 8191) : 8192 + ((m - MP) & 7);
            const float c = rope[((size_t)pos * 16 + lane) * 2], s = rope[((size_t)pos * 16 + lane) * 2 + 1];
            const float o1 = x1 * c - x2 * s, o2 = x1 * s + x2 * c;
            float* dst = (m < MP) ? (A->out + O_KRP + (size_t)m * 32) : (A->out + O_KRS + (size_t)(m - MP) * 32);
            dst[lane] = o1; dst[16 + lane] = o2;
            *(unsigned*)((bf16*)(ws + WS_KRB) + (size_t)m * 32 + 2 * lane) = pk2(o1, o2); }
        { v4u o; o.x = pk2(uu[0], uu[1]); o.y = pk2(uu[2], uu[3]); o.z = pk2(uu[4], uu[5]); o.w = pk2(uu[6], uu[7]); *(v4u*)((bf16*)(ws + WS_U) + (size_t)m * 512 + 8 * lane) = o; }
        { float y[8];
          y[0] = vv[0] * rv * gv0.x + bv0.x; y[1] = vv[1] * rv * gv0.y + bv0.y; y[2] = vv[2] * rv * gv0.z + bv0.z; y[3] = vv[3] * rv * gv0.w + bv0.w;
          y[4] = vv[4] * rv * gv1.x + bv1.x; y[5] = vv[5] * rv * gv1.y + bv1.y; y[6] = vv[6] * rv * gv1.z + bv1.z; y[7] = vv[7] * rv * gv1.w + bv1.w;
          v4u o; o.x = pk2(y[0], y[1]); o.y = pk2(y[2], y[3]); o.z = pk2(y[4], y[5]); o.w = pk2(y[6], y[7]); *(v4u*)((bf16*)(ws + WS_VB) + (size_t)m * 512 + 8 * lane) = o;
          if (m >= MP) { float* dst = A->out + O_VS + (size_t)(m - MP) * 512 + 8 * lane; *(f32x4*)dst = (f32x4){y[0], y[1], y[2], y[3]}; *(f32x4*)(dst + 4) = (f32x4){y[4], y[5], y[6], y[7]}; } }
    }
}

__device__ __forceinline__ void p7_xn2(kargs_t A, const Ctx& C) {
    const int gw = C.vcu * NWAVES + C.wave, NGW = C.G * NWAVES;
    for (int m = gw; m < MT; m += NGW) rms_row_to_bf16((const float*)(A->ws + WS_X1) + (size_t)m * DM, (bf16*)(A->ws + WS_XN2) + (size_t)m * DM, C.lane);
}
__device__ __forceinline__ void p10_final(kargs_t A, const Ctx& C) {
    const int gw = C.vcu * NWAVES + C.wave, NGW = C.G * NWAVES, lane = C.lane;
    f32x4 g[4];
#pragma unroll
    for (int j = 0; j < 4; ++j) g[j] = *((const f32x4*)A->in[23] + lane + 64 * j);
    for (int m = gw; m < MT; m += NGW) {
        GAS f32x4* xr = (GAS f32x4*)(A->out + O_Y + (size_t)m * DM) + lane;
        f32x4 v[4]; float s = 0.f;
#pragma unroll
        for (int j = 0; j < 4; ++j) { v[j] = xr[64 * j]; s += (v[j].x * v[j].x + v[j].y * v[j].y) + (v[j].z * v[j].z + v[j].w * v[j].w); }
        const float rstd = 1.f / sqrtf(wave_sum(s) * (1.f / 1024.f) + EPSN);
#pragma unroll
        for (int j = 0; j < 4; ++j) xr[64 * j] = v[j] * rstd * g[j];
    }
}

typedef float f32x16 __attribute__((ext_vector_type(16)));
typedef short s16x4 __attribute__((ext_vector_type(4)));
typedef LAS const unsigned char* ldsc_t;
__device__ __forceinline__ int crow16(int r, int hi) { return (r & 3) + 8 * (r >> 2) + 4 * hi; }
__device__ __forceinline__ s16x4 tr_read(ldsc_t p) { typedef short v4i16_t __attribute__((ext_vector_type(4))); return __builtin_bit_cast(s16x4, __builtin_amdgcn_ds_read_tr16_b64_v4i16((LAS v4i16_t*)p)); }
#define MFMA32(a, b, c) __builtin_amdgcn_mfma_f32_32x32x16_bf16(a, b, c, 0, 0, 0)

constexpr int DEC_QI = 0, DEC_KI = 37888, DEC_PI = DEC_KI + 75776, DEC_MX = DEC_PI + 17408, DEC_SM = DEC_MX + 1024, DEC_AL = DEC_SM + 1024, DEC_END = DEC_AL + 256;
constexpr int DEC_KP = 592, DEC_PP = 272;
static_assert(DEC_END <= MISC_OFF, "decode LDS map");
__device__ __forceinline__ void decode_item(kargs_t A, const Ctx& C, int s, int sp) {
    const int tid = C.tid, lane = C.lane, wid = C.wave, r32 = lane & 31, hi = lane >> 5;
    LAS unsigned char* lds = C.lds;
    const float* cck = A->in[2]; const float* ckr = A->in[3]; const int* ptab = (const int*)A->in[4] + s * 64 + 32 * sp;
    { const bf16* Qs = (const bf16*)(A->ws + WS_Q) + (size_t)(MP + 8 * s) * NQ; const bf16* WU = (const bf16*)(A->ws + WS_WUKB);
      for (int it = wid; it < 64; it += 8) { const int ct = it & 7, h = it >> 3;
          f32x16 acc = {};
#pragma unroll
          for (int ks = 0; ks < 4; ++ks) {
              const bf16x8 a = *(const bf16x8*)(Qs + (size_t)(r32 & 7) * NQ + 96 * h + 16 * ks + 8 * hi);
              const bf16x8 b = *(const bf16x8*)(WU + (size_t)(32 * ct + r32) * 512 + 64 * h + 16 * ks + 8 * hi);
              acc = MFMA32(a, b, acc); }
#pragma unroll
          for (int r = 0; r < 4; ++r) *(LAS bf16*)(lds + DEC_QI + ((r + 4 * hi) * 8 + h) * DEC_KP + (32 * ct + r32) * 2) = (bf16)f2bf(acc[r]); }
      for (int e = tid; e < 2048; e += 512) { const int qq = e >> 5, i = e & 31, t = qq >> 3, h = qq & 7;
          *(LAS bf16*)(lds + DEC_QI + qq * DEC_KP + (256 + i) * 2) = Qs[(size_t)t * NQ + 96 * h + 64 + ((i < 16) ? 2 * i : 2 * (i - 16) + 1)]; } }
    const int kb = wid & 3, qb = wid >> 2;
    const int q = 32 * qb + r32;
    float m_run = -INFINITY, l_run = 0.f; f32x16 o0 = {}, o1 = {};
    const int NT = 32 + sp;
    f32x4 pre[18];
#define DEC_LOAD(tile) do { if ((tile) < 32) { const int pg = ptab[(tile)]; const float* pc = cck + (size_t)pg * 32768; const float* pr = ckr + (size_t)pg * 4096; \
        _Pragma("unroll") for (int i = 0; i < 16; ++i) pre[i] = *(const f32x4*)(pc + 4 * (size_t)(tid + 512 * i)); \
        _Pragma("unroll") for (int i = 0; i < 2; ++i) pre[16 + i] = *(const f32x4*)(pr + 4 * (size_t)(tid + 512 * i)); } \
      else { _Pragma("unroll") for (int i = 0; i < 18; ++i) pre[i] = (f32x4){0.f, 0.f, 0.f, 0.f}; \
        pre[0] = *(const f32x4*)(A->out + O_CKVS + (size_t)s * 2048 + 4 * tid); if (tid < 64) pre[16] = *(const f32x4*)(A->out + O_KRS + (size_t)s * 256 + 4 * tid); } } while (0)
    DEC_LOAD(0);
    for (int t = 0; t < NT; ++t) {
#pragma unroll
        for (int i = 0; i < 16; ++i) { const int f = tid + 512 * i; *(LAS unsigned long long*)(lds + DEC_KI + (f >> 6) * DEC_KP + (f & 63) * 8) = (unsigned long long)pk2(pre[i].x, pre[i].y) | ((unsigned long long)pk2(pre[i].z, pre[i].w) << 32); }
#pragma unroll
        for (int i = 0; i < 2; ++i) { const int f = tid + 512 * i; *(LAS unsigned long long*)(lds + DEC_KI + (f >> 3) * DEC_KP + 512 + (f & 7) * 8) = (unsigned long long)pk2(pre[16 + i].x, pre[16 + i].y) | ((unsigned long long)pk2(pre[16 + i].z, pre[16 + i].w) << 32); }
        if (t + 1 < NT) DEC_LOAD(t + 1);
        LBAR();
        f32x16 sc = {};
        { ldsc_t ka = lds + DEC_KI + (32 * kb + r32) * DEC_KP + hi * 16, qa = lds + DEC_QI + q * DEC_KP + hi * 16;
#pragma unroll
          for (int ks = 0; ks < 18; ++ks) { const bf16x8 a = *(LAS const bf16x8*)(ka + ks * 32), b = *(LAS const bf16x8*)(qa + ks * 32); sc = MFMA32(a, b, sc); } }
        if (t == 32) { const int tq = q >> 3;
#pragma unroll
            for (int r = 0; r < 16; ++r) if (32 * kb + crow16(r, hi) > tq) sc[r] = -INFINITY; }
        float mx = sc[0];
#pragma unroll
        for (int r = 1; r < 16; ++r) mx = fmaxf(mx, sc[r]);
        mx = fmaxf(mx, __shfl_xor(mx, 32));
        if (hi == 0) *(LAS float*)(lds + DEC_MX + (kb * 64 + q) * 4) = mx;
        LBAR();
        float tm = *(LAS const float*)(lds + DEC_MX + q * 4);
#pragma unroll
        for (int k = 1; k < 4; ++k) tm = fmaxf(tm, *(LAS const float*)(lds + DEC_MX + (k * 64 + q) * 4));
        const float m_new = fmaxf(m_run, tm), alpha = __builtin_amdgcn_exp2f(m_run - m_new);
        float ps = 0.f;
#pragma unroll
        for (int r = 0; r < 16; ++r) { sc[r] = __builtin_amdgcn_exp2f(sc[r] - m_new); ps += sc[r]; }
        ps += __shfl_xor(ps, 32);
#pragma unroll
        for (int i = 0; i < 4; ++i) *(LAS unsigned long long*)(lds + DEC_PI + q * DEC_PP + (32 * kb + 8 * i + 4 * hi) * 2) = (unsigned long long)pk2(sc[4 * i], sc[4 * i + 1]) | ((unsigned long long)pk2(sc[4 * i + 2], sc[4 * i + 3]) << 32);
        if (hi == 0) { *(LAS float*)(lds + DEC_SM + (kb * 64 + q) * 4) = ps; if (kb == 0) *(LAS float*)(lds + DEC_AL + q * 4) = alpha; }
        m_run = m_new;
        LBAR();
        { float ss = 0.f;
#pragma unroll
          for (int k = 0; k < 4; ++k) ss += *(LAS const float*)(lds + DEC_SM + (k * 64 + q) * 4);
          l_run = l_run * alpha + ss; }
#pragma unroll
        for (int r = 0; r < 16; ++r) { const float al = *(LAS const float*)(lds + DEC_AL + (32 * qb + crow16(r, hi)) * 4); o0[r] *= al; o1[r] *= al; }
        { ldsc_t pa = lds + DEC_PI + q * DEC_PP + hi * 16;
          ldsc_t va = lds + DEC_KI + (8 * hi + ((lane & 15) >> 2)) * DEC_KP + (64 * kb + 16 * ((lane >> 4) & 1) + 4 * (lane & 3)) * 2;
#pragma unroll
          for (int ks = 0; ks < 8; ++ks) {
              const bf16x8 a = *(LAS const bf16x8*)(pa + ks * 32);
              const s16x4 v00 = tr_read(va + ks * 16 * DEC_KP), v01 = tr_read(va + (ks * 16 + 4) * DEC_KP), v10 = tr_read(va + ks * 16 * DEC_KP + 64), v11 = tr_read(va + (ks * 16 + 4) * DEC_KP + 64);
              o0 = MFMA32(a, ((bf16x8){v00[0], v00[1], v00[2], v00[3], v01[0], v01[1], v01[2], v01[3]}), o0);
              o1 = MFMA32(a, ((bf16x8){v10[0], v10[1], v10[2], v10[3], v11[0], v11[1], v11[2], v11[3]}), o1);
          } }
        LBAR();
    }
#undef DEC_LOAD
    int qo = q, r32o = r32; asm volatile("" : "+v"(qo), "+v"(r32o));
    if (kb == 0 && hi == 0) { float* ml = (float*)(A->ws + WS_ML) + ((size_t)(s * 2 + sp) * 64 + qo) * 2; ml[0] = m_run; ml[1] = l_run; }
    { float* op = (float*)(A->ws + WS_OPART) + (size_t)(s * 2 + sp) * 64 * 256;
#pragma unroll
      for (int r = 0; r < 16; ++r) { const int row = 32 * qb + crow16(r, hi); op[(size_t)row * 256 + 64 * kb + r32o] = o0[r]; op[(size_t)row * 256 + 64 * kb + 32 + r32o] = o1[r]; } }
}
__device__ __forceinline__ void p4_decode(kargs_t A, const Ctx& C) {
    for (int it = C.vcu; it < 256; it += C.G) { decode_item(A, C, it >> 1, it & 1); LBAR(); }
}

__device__ __forceinline__ void gate_prompt_item(kargs_t A, const Ctx& C, int ci) {
    const int lane = C.lane, g = C.wave, r32 = lane & 31, hi = lane >> 5; const int R0 = 128 * ci;
    LAS unsigned char* img = C.lds + g * 16384;
    const bf16* Vb = (const bf16*)(A->ws + WS_VB); const bf16* U = (const bf16*)(A->ws + WS_U); const bf16* WS = (const bf16*)(A->ws + WS_WSB) + (size_t)g * 16384;
    bf16* MG = (bf16*)(A->ws + WS_MG);
#pragma unroll
    for (int i = 0; i < 16; ++i) { const int e = lane + 64 * i, row = e >> 3, ch = e & 7;
        *(LAS v4u*)(img + (ch >> 2) * 8192 + row * 64 + (ch & 3) * 16) = *(const v4u*)(Vb + (size_t)(R0 + row) * 512 + 64 * g + ch * 8); }
    LDS_WAIT(); asm volatile("" ::: "memory");
    ldsc_t va = img + (8 * hi + ((lane & 15) >> 2)) * 64 + (16 * ((lane >> 4) & 1) + 4 * (lane & 3)) * 2;
    LAS float* ssq = (LAS float*)(C.lds + LDS_X);
#pragma unroll
    for (int hf = 0; hf < 2; ++hf) {
        f32x16 acc[2][2];
#pragma unroll
        for (int mm = 0; mm < 2; ++mm) { acc[mm][0] = (f32x16){}; acc[mm][1] = (f32x16){}; }
#pragma unroll
        for (int mm = 0; mm < 2; ++mm) { const int mt = 2 * hf + mm;
#pragma unroll
            for (int ks = 0; ks < 2 * mt + 2; ++ks) {
                const bf16x8 b = *(const bf16x8*)(WS + (size_t)(32 * mt + r32) * 128 + 16 * ks + 8 * hi);
#pragma unroll
                for (int nt = 0; nt < 2; ++nt) { const s16x4 v0 = tr_read(va + nt * 8192 + ks * 16 * 64), v1 = tr_read(va + nt * 8192 + (ks * 16 + 4) * 64);
                    acc[mm][nt] = MFMA32(((bf16x8){v0[0], v0[1], v0[2], v0[3], v1[0], v1[1], v1[2], v1[3]}), b, acc[mm][nt]); }
            } }
#pragma unroll
        for (int mm = 0; mm < 2; ++mm) { const int i = 32 * (2 * hf + mm) + r32; const float bs = A->in[15][g * 128 + i]; float sq = 0.f;
#pragma unroll
            for (int nt = 0; nt < 2; ++nt)
#pragma unroll
                for (int qd = 0; qd < 4; ++qd) { const unsigned long long uw = *(const unsigned long long*)(U + (size_t)(R0 + i) * 512 + 64 * g + 32 * nt + 8 * qd + 4 * hi);
                    const float u0 = bflo((unsigned)uw), u1 = bfhi((unsigned)uw), u2 = bflo((unsigned)(uw >> 32)), u3 = bfhi((unsigned)(uw >> 32));
                    const float g0 = u0 * (acc[mm][nt][4 * qd] + bs), g1 = u1 * (acc[mm][nt][4 * qd + 1] + bs), g2 = u2 * (acc[mm][nt][4 * qd + 2] + bs), g3 = u3 * (acc[mm][nt][4 * qd + 3] + bs);
                    acc[mm][nt][4 * qd] = g0; acc[mm][nt][4 * qd + 1] = g1; acc[mm][nt][4 * qd + 2] = g2; acc[mm][nt][4 * qd + 3] = g3;
                    sq += (g0 * g0 + g1 * g1) + (g2 * g2 + g3 * g3); }
            sq += __shfl_xor(sq, 32);
            if (hi == 0) ssq[g * 128 + i] = sq; }
        LBAR();
#pragma unroll
        for (int mm = 0; mm < 2; ++mm) { const int i = 32 * (2 * hf + mm) + r32; float t = 0.f;
#pragma unroll
            for (int k = 0; k < 8; ++k) t += ssq[k * 128 + i];
            const float rs = 1.f / sqrtf(t * (1.f / 512.f) + EPSN);
#pragma unroll
            for (int nt = 0; nt < 2; ++nt)
#pragma unroll
                for (int qd = 0; qd < 4; ++qd)
                    *(unsigned long long*)(MG + (size_t)(R0 + i) * 1024 + 512 + 64 * g + 32 * nt + 8 * qd + 4 * hi) =
                        (unsigned long long)pk2(acc[mm][nt][4 * qd] * rs, acc[mm][nt][4 * qd + 1] * rs) | ((unsigned long long)pk2(acc[mm][nt][4 * qd + 2] * rs, acc[mm][nt][4 * qd + 3] * rs) << 32); }
    }
    const bf16* AT = (const bf16*)(A->ws + WS_ATT);
    for (int rr = 0; rr < 16; ++rr) { const size_t row = (size_t)R0 + 16 * g + rr; const v4u w = *(const v4u*)(AT + row * 512 + 8 * lane);
        float x[8] = {bflo(w.x), bfhi(w.x), bflo(w.y), bfhi(w.y), bflo(w.z), bfhi(w.z), bflo(w.w), bfhi(w.w)}; float sq = 0.f;
#pragma unroll
        for (int k = 0; k < 8; ++k) sq += x[k] * x[k];
        const float rs = 1.f / sqrtf(wave_sum(sq) * (1.f / 512.f) + EPSN);
        v4u o; o.x = pk2(x[0] * rs, x[1] * rs); o.y = pk2(x[2] * rs, x[3] * rs); o.z = pk2(x[4] * rs, x[5] * rs); o.w = pk2(x[6] * rs, x[7] * rs);
        *(v4u*)(MG + row * 1024 + 8 * lane) = o; }
    LBAR();
}
__device__ __forceinline__ void gate_sample_item(kargs_t A, const Ctx& C, int s) {
    const int tid = C.tid, lane = C.lane, h = C.wave;
    LAS float* ol = (LAS float*)C.lds;
    LAS float* red = (LAS float*)(C.lds + 65536);
    bf16* MG = (bf16*)(A->ws + WS_MG);
    { const float* ml = (const float*)(A->ws + WS_ML) + (size_t)s * 2 * 64 * 2; const float* op = (const float*)(A->ws + WS_OPART) + (size_t)s * 2 * 64 * 256;
      for (int e = tid; e < 4096; e += 512) { const int row = e >> 6, c4 = e & 63;
          const float m0 = ml[row * 2], l0 = ml[row * 2 + 1], m1 = ml[(64 + row) * 2], l1 = ml[(64 + row) * 2 + 1];
          const float mm = fmaxf(m0, m1), w0 = __builtin_amdgcn_exp2f(m0 - mm), w1 = __builtin_amdgcn_exp2f(m1 - mm), inv = 1.f / (w0 * l0 + w1 * l1);
          const f32x4 a = *(const f32x4*)(op + (size_t)row * 256 + 4 * c4), b = *(const f32x4*)(op + (size_t)(64 + row) * 256 + 4 * c4);
          *(LAS f32x4*)(ol + row * 256 + 4 * c4) = (a * w0 + b * w1) * inv; } }
    LBAR();
    float av[8];
#pragma unroll
    for (int t = 0; t < 8; ++t) av[t] = 0.f;
    { const bf16* wr = (const bf16*)(A->ws + WS_WKV) + (size_t)(512 + 64 * h + lane) * 256;
      for (int r0 = 0; r0 < 256; r0 += 8) { const v4u w = *(const v4u*)(wr + r0);
          const float wf[8] = {bflo(w.x), bfhi(w.x), bflo(w.y), bfhi(w.y), bflo(w.z), bfhi(w.z), bflo(w.w), bfhi(w.w)};
#pragma unroll
          for (int t = 0; t < 8; ++t) { const f32x4 x0 = *(LAS const f32x4*)(ol + (t * 8 + h) * 256 + r0), x1 = *(LAS const f32x4*)(ol + (t * 8 + h) * 256 + r0 + 4);
              av[t] += (x0.x * wf[0] + x0.y * wf[1]) + (x0.z * wf[2] + x0.w * wf[3]) + (x1.x * wf[4] + x1.y * wf[5]) + (x1.z * wf[6] + x1.w * wf[7]); } } }
#pragma unroll
    for (int t = 0; t < 8; ++t) { const float sq = wave_sum(av[t] * av[t]); if (lane == 0) red[h * 8 + t] = sq; }
    LBAR();
#pragma unroll
    for (int t = 0; t < 8; ++t) { float tt = 0.f;
#pragma unroll
        for (int k = 0; k < 8; ++k) tt += red[k * 8 + t];
        const float rs = 1.f / sqrtf(tt * (1.f / 512.f) + EPSN);
        MG[(size_t)(MP + 8 * s + t) * 1024 + 64 * h + lane] = (bf16)f2bf(av[t] * rs); }
    LBAR();
    { const int c = tid, g = h; const bf16* Vb = (const bf16*)(A->ws + WS_VB) + (size_t)(MP + 8 * s) * 512 + c; const bf16* U = (const bf16*)(A->ws + WS_U) + (size_t)(MP + 8 * s) * 512 + c;
      float vv[8], gg[8];
#pragma unroll
      for (int j = 0; j < 8; ++j) vv[j] = bf2f(Vb[j * 512]);
#pragma unroll
      for (int t = 0; t < 8; ++t) { float mix = A->in[15][g * 128 + t];
#pragma unroll
          for (int j = 0; j < 8; ++j) if (j <= t) mix += A->in[14][(size_t)g * 16384 + t * 128 + j] * vv[j];
          gg[t] = bf2f(U[t * 512]) * mix; const float sq = wave_sum(gg[t] * gg[t]); if (lane == 0) red[g * 8 + t] = sq; }
      LBAR();
#pragma unroll
      for (int t = 0; t < 8; ++t) { float tt = 0.f;
#pragma unroll
          for (int k = 0; k < 8; ++k) tt += red[k * 8 + t];
          const float rs = 1.f / sqrtf(tt * (1.f / 512.f) + EPSN);
          MG[(size_t)(MP + 8 * s + t) * 1024 + 512 + c] = (bf16)f2bf(gg[t] * rs); } }
    LBAR();
}
__device__ __forceinline__ void p5_gate(kargs_t A, const Ctx& C) {
    for (int it = C.vcu; it < 256; it += C.G) { if (it < 128) gate_prompt_item(A, C, it); else gate_sample_item(A, C, it - 128); }
}

__global__ void __launch_bounds__(NWAVES * 64, 2) mk_fwd(Args args_unused) {
    extern __shared__ __attribute__((aligned(16))) unsigned char lds_raw[];
    const int wave_s = __builtin_amdgcn_readfirstlane(threadIdx.x >> 6);
    const int G_s = gridDim.x; const int vcu_s = (G_s % 8 == 0) ? ((int)blockIdx.x % 8) * (G_s / 8) + (int)blockIdx.x / 8 : (int)blockIdx.x;
#define MKCTX() Ctx C; C.lds = (LAS unsigned char*)lds_raw; C.wave = wave_s; C.lane = lane_now(); C.tid = wave_s * 64 + C.lane; C.G = G_s; C.vcu = vcu_s
#define T0() (wave_s == 0 && lane_now() == 0)
    volatile LAS unsigned* MISC = (volatile LAS unsigned*)((LAS unsigned char*)lds_raw + MISC_OFF);
    if (wave_s == 0) MISC[lane_now()] = 0u;
    __syncthreads();
    int lo, hi; gu32* ctl; { kargs_t A0 = KARGS(); lo = A0->ph_lo; hi = A0->ph_hi; ctl = (gu32*)(A0->ws + WS_CTL); }
    const bool multi = (hi - lo) > 1;
    XcdBarrier bar; bar.bar = (unsigned*)(ctl + CW_BAR); bar.x = 0; bar.st = nullptr;
    if (multi) bar = xcd_barrier_post((unsigned*)(ctl + CW_BAR), MISC, T0());
#ifndef PH_MASK
#define PH_MASK 0x7ff
#endif
#define IN(k) (((PH_MASK >> (k)) & 1) && lo <= (k) && (k) < hi)
#define SEAM(k) do { if (IN(k) && IN((k) + 1)) xcd_barrier(bar, T0()); } while (0)

    if (IN(0)) { MKCTX(); p0_prologue(KARGS(), C); }
    SEAM(0);
    if (IN(1)) { MKCTX(); unsigned char* ws = KARGS()->ws;
        pg8::Gemm g{(const bf16*)(ws + WS_XN), (const bf16*)(ws + WS_WIN), MT, NZ, DM}; pg8::StaticOrder S; S.init(MT, NZ, C.G, (int)blockIdx.x);
        pg8::EpiBf16<0> E{(bf16*)(ws + WS_Z), NZ, nullptr, 0, 0, 1.f};
        pg8::gemm_phase<pg8::EpiBf16<0>, pg8::StaticOrder, PG8_ALIGN, PG8_SP2>(C.lds + RING_OFF, g, S, E, wave_s);
    }
    SEAM(1);
    if (IN(2)) { MKCTX(); p2_post(KARGS(), C); }
    SEAM(2);
    if (IN(3)) { MKCTX(); unsigned char* ws = KARGS()->ws;
#ifndef NO_QUP
        { pg8::Gemm g{(const bf16*)(ws + WS_CQN), (const bf16*)(ws + WS_WQUP), MT, NQ, QRK}; pg8::StaticOrder S; S.init(MT, NQ, C.G, (int)blockIdx.x);
          pg8::EpiQ E{(bf16*)(ws + WS_Q), (const float*)(ws + WS_ROPE), QSCALE};
          pg8::gemm_phase<pg8::EpiQ, pg8::StaticOrder, PG8_ALIGN, PG8_SP2>(C.lds + RING_OFF, g, S, E, wave_s); }
#endif
#ifndef NO_KV
        { pg8::Gemm g{(const bf16*)(ws + WS_CKVB), (const bf16*)(ws + WS_WKV), MP, 1024, 256}; pg8::StaticOrder S; S.init(MP, 1024, C.G, (int)blockIdx.x);
          pg8::EpiBf16<0> E{(bf16*)(ws + WS_KN), 512, nullptr, 512, (size_t)(WS_VH - WS_KN) / 2, 1.f};
          pg8::gemm_phase<pg8::EpiBf16<0>, pg8::StaticOrder, PG8_ALIGN, PG8_SP2>(C.lds + RING_OFF, g, S, E, wave_s); }
#endif
    }
    SEAM(3);
    if (IN(4)) { MKCTX(); kargs_t A4 = KARGS(); unsigned char* ws = A4->ws;
        static_assert(attn_body::ATTN_LDS_BYTES <= RING_BYTES, "attention body LDS");
        const attn_body::AttnTensors AT{(const attn_body::bf16*)(ws + WS_Q), (const attn_body::bf16*)(ws + WS_KN), (const attn_body::bf16*)(ws + WS_KRB), (const attn_body::bf16*)(ws + WS_VH), (attn_body::bf16*)(ws + WS_ATT)};
        const attn_body::StaticOrder S((int)C.G, (int)blockIdx.x);
#ifndef NO_ATTN
        attn_body::attn_phase<attn_body::StaticOrder>((char*)lds_raw + RING_OFF, AT, S, wave_s);
#endif
#ifndef NO_DEC
        { Ctx C2 = C; C2.lane = lane_now(); C2.tid = wave_s * 64 + C2.lane; p4_decode(A4, C2); }
#endif
    }
    SEAM(4);
    if (IN(5)) { MKCTX(); p5_gate(KARGS(), C); }
    SEAM(5);
    if (IN(6)) { MKCTX(); kargs_t A6 = KARGS(); unsigned char* ws = A6->ws;
        pg8::Gemm g{(const bf16*)(ws + WS_MG), (const bf16*)(ws + WS_WOUT), MT, DM, DM}; pg8::StaticOrder S; S.init(MT, DM, C.G, (int)blockIdx.x);
        pg8::EpiResF32 E{A6->in[0], A6->in[1], (float*)(ws + WS_X1), DM};
        pg8::gemm_phase<pg8::EpiResF32, pg8::StaticOrder, PG8_ALIGN, PG8_SP2>(C.lds + RING_OFF, g, S, E, wave_s);
    }
    SEAM(6);
    if (IN(7)) { MKCTX(); p7_xn2(KARGS(), C); }
    SEAM(7);
    if (IN(8)) { MKCTX(); unsigned char* ws = KARGS()->ws;
        pg8::Gemm g{(const bf16*)(ws + WS_XN2), (const bf16*)(ws + WS_WGU), MT, NGU, DM}; pg8::StaticOrder S; S.init(MT, NGU, C.G, (int)blockIdx.x);
        pg8::EpiSwiGLU E{(bf16*)(ws + WS_H), FFN};
        pg8::gemm_phase<pg8::EpiSwiGLU, pg8::StaticOrder, PG8_ALIGN, PG8_SP2>(C.lds + RING_OFF, g, S, E, wave_s);
    }
    SEAM(8);
    if (IN(9)) { MKCTX(); kargs_t A9 = KARGS(); unsigned char* ws = A9->ws;
        pg8::Gemm g{(const bf16*)(ws + WS_H), (const bf16*)(ws + WS_WDN), MT, DM, FFN}; pg8::StaticOrder S; S.init(MT, DM, C.G, (int)blockIdx.x);
        pg8::EpiResF32 E{(const float*)(ws + WS_X1), (const float*)(ws + WS_X1) + (size_t)MP * DM, A9->out + O_Y, DM};
        pg8::gemm_phase<pg8::EpiResF32, pg8::StaticOrder, PG8_ALIGN, PG8_SP2>(C.lds + RING_OFF, g, S, E, wave_s);
    }
    SEAM(9);
    if (IN(10)) { MKCTX(); p10_final(KARGS(), C); }
#undef IN
#undef SEAM
#undef MKCTX
#undef T0
}

extern "C" void kernel_launch(void* const* d_in, const int* in_sizes, int n_in, void* d_out, int out_size, void* d_ws, size_t ws_size, hipStream_t stream) {
    static int grid = 0;
    if (grid == 0) {
        if (n_in != 24 || (size_t)out_size != O_END || ws_size < WS_END) { fprintf(stderr, "kernel_launch: unexpected problem (n_in %d, out %d, ws %zu); nothing launched\n", n_in, out_size, ws_size); grid = -1; return; }
        int dev = 0, cus = 0, per_cu = 0;
        if (hipGetDevice(&dev) != hipSuccess || hipDeviceGetAttribute(&cus, hipDeviceAttributeMultiprocessorCount, dev) != hipSuccess) { grid = -1; return; }
        if (hipFuncSetAttribute((const void*)mk_fwd, hipFuncAttributeMaxDynamicSharedMemorySize, LDS_BYTES) != hipSuccess) { fprintf(stderr, "kernel_launch: hipFuncSetAttribute failed\n"); grid = -1; return; }
        if (hipOccupancyMaxActiveBlocksPerMultiprocessor(&per_cu, (const void*)mk_fwd, NWAVES * 64, LDS_BYTES) != hipSuccess || per_cu < 1) { fprintf(stderr, "kernel_launch: occupancy query says %d\n", per_cu); }
        (void)hipGetLastError();
        grid = cus;
        if (grid != 256) fprintf(stderr, "kernel_launch: %d CUs (built for 256)\n", grid);
    }
    if (grid < 0) return;
    (void)hipMemsetAsync((char*)d_ws + WS_CTL, 0, CTL_ZERO_BYTES, stream);
    Args a{};
    for (int i = 0; i < 24; ++i) a.in[i] = (const float*)d_in[i];
    a.out = (float*)d_out; a.ws = (unsigned char*)d_ws;
#if MK_N_LAUNCHES == 1
    a.ph_lo = 0; a.ph_hi = N_PHASES;
    hipLaunchKernelGGL(mk_fwd, dim3(grid), dim3(NWAVES * 64), LDS_BYTES, stream, a);
#else
    for (int p = 0; p < N_PHASES; ++p) { a.ph_lo = p; a.ph_hi = p + 1; hipLaunchKernelGGL(mk_fwd, dim3(grid), dim3(NWAVES * 64), LDS_BYTES, stream, a); }
#endif
}
```

```cpp
#include <hip/hip_runtime.h>
#include <cstdio>
#include <cstdint>
__device__ __forceinline__ int lane_now() { int l; asm volatile("v_mbcnt_lo_u32_b32 %0, -1, 0\n\tv_mbcnt_hi_u32_b32 %0, -1, %0" : "=v"(l)); return l; }
namespace pg8 {
#define PG8_LAS __attribute__((address_space(3)))
typedef unsigned short bf16_t;
typedef short bf16x8 __attribute__((ext_vector_type(8)));
typedef float f32x4 __attribute__((ext_vector_type(4)));
typedef unsigned u32x4 __attribute__((ext_vector_type(4)));
constexpr int BM = 256, BK = 64, HALF = 128, HTB = HALF * BK * 2  , STAGE_BYTES = 8 * HTB, NXCD = 8, WGM = 8;

__host__ __device__ __forceinline__ int lds_byte(int r, int c) { const int st = (r >> 4) * 2 + (c >> 5), rr = r & 15, cc = c & 31, ob = rr * 64 + cc * 2; return st * 1024 + (ob ^ (((ob >> 9) & 1) << 5)); }
__host__ __device__ __forceinline__ void stage_rc(int b, int& R, int& C) { const int st = b / 1024, sb = b % 1024, swz = sb ^ (((sb >> 9) & 1) << 5); R = (st >> 1) * 16 + swz / 64; C = (st & 1) * 32 + (swz % 64) / 2; }
__host__ __device__ __forceinline__ int perm32(int rho) { const int n = rho >> 4, i = rho & 15; return 8 * (i >> 2) + 4 * n + (i & 3); }

struct Unit { int pm, pn, ks; };
struct Gemm { const bf16_t* A; const bf16_t* Bt; int M, N, K; int ld = 0; };

struct StaticOrder {
    int nM, nN, nwg, G, c;
    __host__ __device__ void init(int M, int N, int G_, int c_) { nM = M / BM; nN = N / BM; nwg = nM * nN; G = G_; c = c_; }
    __host__ __device__ bool next(int i, Unit& u) const {
        const long L = (long)i * G + c; if (L >= nwg) return false;
        int wgid = (int)L; { const int q = nwg / NXCD, r = nwg % NXCD, xcd = wgid % NXCD, off = wgid / NXCD; wgid = (xcd < r ? xcd * (q + 1) : r * (q + 1) + (xcd - r) * q) + off; }
        const int nig = WGM * nN, gid = wgid / nig, fm = gid * WGM, gsz = (nM - fm) < WGM ? (nM - fm) : WGM;
        u.pm = fm + ((wgid % nig) % gsz); u.pn = (wgid % nig) / gsz; u.ks = 0; return true;
    }
    __device__ __forceinline__ void a_ready(const Unit&) const {}
    __device__ __forceinline__ void done(const Unit&) const {}
};

struct SplitKOrder {
    int nM, nN, nS, G, c;
    __host__ __device__ void init(int M, int N, int nS_, int G_, int c_) { nM = M / BM; nN = N / BM; nS = nS_; G = G_; c = c_; }
    __host__ __device__ bool next(int i, Unit& u) const { const int L = i * G + c; if (L >= nM * nN * nS) return false; u.pn = L % nN; u.pm = (L / nN) % nM; u.ks = L / (nN * nM); return true; }
    __device__ __forceinline__ void a_ready(const Unit&) const {}
    __device__ __forceinline__ void done(const Unit&) const {}
};
__device__ __forceinline__ unsigned cvt_pk_bf16(float lo, float hi) { unsigned r; asm volatile("v_cvt_pk_bf16_f32 %0, %1, %2" : "=v"(r) : "v"(lo), "v"(hi)); return r; }
typedef float f32x2 __attribute__((ext_vector_type(2)));
__device__ __forceinline__ f32x2 gelu_pk(f32x2 v) {
    const f32x2 av = __builtin_elementwise_abs(v), d = av * 0.2316418882f + 1.0f;
    f32x2 t; t.x = __builtin_amdgcn_rcpf(d.x); t.y = __builtin_amdgcn_rcpf(d.y);
    f32x2 q = t * 0.5307027145f + (-0.7265760135f); q = q * t + 0.7107068705f; q = q * t + (-0.142248368f); q = q * t + 0.127414796f; q = q * t;
    const f32x2 s = (v * v) * (-0.72134752044f);
    f32x2 e; e.x = __builtin_amdgcn_exp2f(s.x); e.y = __builtin_amdgcn_exp2f(s.y);
    const f32x2 m = v * (q * e), r = v - m;
    f32x2 o; o.x = v.x < 0.f ? m.x : r.x; o.y = v.y < 0.f ? m.y : r.y; return o;
}

template <int ACT  > struct EpiBf16 {
    static constexpr bool PERM = true, AFTER_DRAIN = false; static_assert(ACT == 0 || ACT == 1, "EpiBf16: ACT is 0 (none) or 1 (gelu_pk)");
    bf16_t* O; int ldc; const float* bias; int split_cols; size_t split_stride; float scale0;
    __device__ __forceinline__ void operator()(const f32x4 (&acc)[2][2][4][2], const Unit& u, int wr, int wc, int fr, int fq) const {
        const int row0 = u.pm * BM + wr * 64 + fr; int colt = u.pn * BM; bf16_t* base = O;
        float sc = 1.f; if (split_cols) { const int t = colt / split_cols; base += (size_t)t * split_stride; colt -= t * split_cols; if (t == 0) sc = scale0; }
        const int col0 = colt + wc * 32 + 8 * fq, bcol0 = u.pn * BM + wc * 32 + 8 * fq;
        f32x4 bv[2][2];
#pragma unroll
        for (int bj = 0; bj < 2; ++bj)
#pragma unroll
            for (int n = 0; n < 2; ++n) bv[bj][n] = bias ? *(const f32x4*)(bias + bcol0 + bj * HALF + 4 * n) : (f32x4){0.f, 0.f, 0.f, 0.f};
#pragma unroll
        for (int ai = 0; ai < 2; ++ai)
#pragma unroll
            for (int m = 0; m < 4; ++m) { bf16_t* rowp = base + (size_t)(row0 + ai * HALF + m * 16) * ldc + col0;
#pragma unroll
                for (int bj = 0; bj < 2; ++bj) { f32x4 v0 = acc[ai][bj][m][0] + bv[bj][0], v1 = acc[ai][bj][m][1] + bv[bj][1];
                    if (ACT == 1) { f32x2 a = gelu_pk((f32x2){v0[0], v0[1]}), b = gelu_pk((f32x2){v0[2], v0[3]}), c = gelu_pk((f32x2){v1[0], v1[1]}), d = gelu_pk((f32x2){v1[2], v1[3]});
                        v0 = (f32x4){a.x, a.y, b.x, b.y}; v1 = (f32x4){c.x, c.y, d.x, d.y}; }
                    v0 = v0 * sc; v1 = v1 * sc; u32x4 w; w.x = cvt_pk_bf16(v0[0], v0[1]); w.y = cvt_pk_bf16(v0[2], v0[3]); w.z = cvt_pk_bf16(v1[0], v1[1]); w.w = cvt_pk_bf16(v1[2], v1[3]);
                    *(u32x4*)(rowp + bj * HALF) = w; } }
    }
};

struct EpiQ {
    static constexpr bool PERM = true, AFTER_DRAIN = false;
    bf16_t* O; const float* rope; float qscale;
    __device__ __forceinline__ void operator()(const f32x4 (&acc)[2][2][4][2], const Unit& u, int wr, int wc, int fr, int fq) const {
        const int row0 = u.pm * BM + wr * 64 + fr, cg0 = u.pn * BM + wc * 32, col0 = cg0 + 8 * fq;
        const bool rp0 = (cg0 % 96) >= 64, rp1 = ((cg0 + HALF) % 96) >= 64;
        const bool prompt = u.pm < 64;
        const float* tp0 = rope + ((size_t)(prompt ? (row0 & 8191) : 8192 + (row0 & 7)) * 16 + 4 * fq) * 2; const int tstride = prompt ? 32 : 0;
#pragma unroll
        for (int ai = 0; ai < 2; ++ai)
#pragma unroll
            for (int m = 0; m < 4; ++m) { const int dr = ai * HALF + m * 16; bf16_t* rowp = O + (size_t)(row0 + dr) * 768 + col0;
#pragma unroll
                for (int bj = 0; bj < 2; ++bj) { f32x4 v0 = acc[ai][bj][m][0], v1 = acc[ai][bj][m][1];
                    if (bj == 0 ? rp0 : rp1) {
                        const f32x4 t0 = *(const f32x4*)(tp0 + dr * tstride), t1 = *(const f32x4*)(tp0 + dr * tstride + 4);
                        const f32x4 a = v0, b = v1;
                        v0[0] = a[0] * t0[0] - a[1] * t0[1]; v0[1] = a[0] * t0[1] + a[1] * t0[0]; v0[2] = a[2] * t0[2] - a[3] * t0[3]; v0[3] = a[2] * t0[3] + a[3] * t0[2];
                        v1[0] = b[0] * t1[0] - b[1] * t1[1]; v1[1] = b[0] * t1[1] + b[1] * t1[0]; v1[2] = b[2] * t1[2] - b[3] * t1[3]; v1[3] = b[2] * t1[3] + b[3] * t1[2];
                    }
                    v0 = v0 * qscale; v1 = v1 * qscale; u32x4 w; w.x = cvt_pk_bf16(v0[0], v0[1]); w.y = cvt_pk_bf16(v0[2], v0[3]); w.z = cvt_pk_bf16(v1[0], v1[1]); w.w = cvt_pk_bf16(v1[2], v1[3]);
                    *(u32x4*)(rowp + bj * HALF) = w; }
                asm volatile("" ::: "memory"); }
    }
};
struct EpiResF32 {
    static constexpr bool PERM = false, AFTER_DRAIN = false;
    const float* base_p; const float* base_s; float* out; int ldc;
    __device__ __forceinline__ void operator()(const f32x4 (&acc)[2][2][4][2], const Unit& u, int wr, int wc, int fr, int fq) const {
        const int row0 = u.pm * BM + wr * 64 + fr, col0 = u.pn * BM + wc * 32 + 4 * fq;
        const float* base = (u.pm < 64) ? base_p : base_s - (size_t)16384 * ldc;
#pragma unroll
        for (int ai = 0; ai < 2; ++ai)
#pragma unroll
            for (int m = 0; m < 4; ++m) { const size_t off = (size_t)(row0 + ai * HALF + m * 16) * ldc + col0;
#pragma unroll
                for (int bj = 0; bj < 2; ++bj)
#pragma unroll
                    for (int n = 0; n < 2; ++n) { const f32x4 b = *(const f32x4*)(base + off + bj * HALF + n * 16); *(f32x4*)(out + off + bj * HALF + n * 16) = b + acc[ai][bj][m][n]; }
                if (m & 1) asm volatile("" ::: "memory"); }
    }
};
struct EpiSwiGLU {
    static constexpr bool PERM = true, AFTER_DRAIN = false;
    bf16_t* H; int ldh;
    static __device__ __forceinline__ float silu_mul(float g, float u) { return g * __builtin_amdgcn_rcpf(1.0f + __builtin_amdgcn_exp2f(-1.4426950408889634f * g)) * u; }
    __device__ __forceinline__ void operator()(const f32x4 (&acc)[2][2][4][2], const Unit& u, int wr, int wc, int fr, int fq) const {
        const int row0 = u.pm * BM + wr * 64 + fr, col0 = u.pn * HALF + wc * 32 + 8 * fq;
#pragma unroll
        for (int ai = 0; ai < 2; ++ai)
#pragma unroll
            for (int m = 0; m < 4; ++m) {
                const f32x4 g0 = acc[ai][0][m][0], g1 = acc[ai][0][m][1], u0 = acc[ai][1][m][0], u1 = acc[ai][1][m][1];
                u32x4 w;
                w.x = cvt_pk_bf16(silu_mul(g0[0], u0[0]), silu_mul(g0[1], u0[1])); w.y = cvt_pk_bf16(silu_mul(g0[2], u0[2]), silu_mul(g0[3], u0[3]));
                w.z = cvt_pk_bf16(silu_mul(g1[0], u1[0]), silu_mul(g1[1], u1[1])); w.w = cvt_pk_bf16(silu_mul(g1[2], u1[2]), silu_mul(g1[3], u1[3]));
                *(u32x4*)(H + (size_t)(row0 + ai * HALF + m * 16) * ldh + col0) = w;
            }
    }
};

struct EpiSlab {
    static constexpr bool PERM = false, AFTER_DRAIN = false;
    float* slab; int M, ldc;
    __device__ __forceinline__ void operator()(const f32x4 (&acc)[2][2][4][2], const Unit& u, int wr, int wc, int fr, int fq) const {
        const int row0 = u.pm * BM + wr * 64 + fr, col0 = u.pn * BM + wc * 32 + 4 * fq; float* base = slab + (size_t)u.ks * M * ldc;
#pragma unroll
        for (int ai = 0; ai < 2; ++ai)
#pragma unroll
            for (int m = 0; m < 4; ++m) { float* rowp = base + (size_t)(row0 + ai * HALF + m * 16) * ldc + col0;
#pragma unroll
                for (int bj = 0; bj < 2; ++bj)
#pragma unroll
                    for (int n = 0; n < 2; ++n) *(f32x4*)(rowp + bj * HALF + n * 16) = acc[ai][bj][m][n]; }
    }
};

template <class Epi, class Sched, bool ALIGN_EPI = false, bool SP2 = false>
__device__ __forceinline__ void gemm_phase(PG8_LAS unsigned char* lds, const Gemm g, const Sched& S, const Epi& E, int wid_s  ) {
    const int wid = wid_s, lane = lane_now(), tid = wid * 64 + lane, wr = wid >> 2, wc = wid & 3, fr = lane & 15, fq = lane >> 4;
    const int K = g.K, LD = g.ld ? g.ld : g.K, nt = K / BK;
    unsigned voffA[2], voffB[2];
#pragma unroll
    for (int i = 0; i < 2; ++i) { int R, C; stage_rc(tid * 16 + i * 8192, R, C); const int Rb = Epi::PERM ? ((R & ~31) + perm32(R & 31)) : R;
        voffA[i] = (unsigned)(R * LD + C) * 2u; voffB[i] = (unsigned)(Rb * LD + C) * 2u; }
    const size_t kstep = (size_t)(BK * 2);
    const size_t hstep = (size_t)HALF * LD * 2;
    const size_t tstep = 2 * hstep;
    const unsigned ldsw = (unsigned)wid * 1024u;
    const int aoff = lds_byte(wr * 64 + fr, fq * 8), boff = lds_byte(wc * 32 + fr, fq * 8);
#define PG8_SA(b, h) (((b) * 2 + (h)) * HTB)
#define PG8_SB(b, h) ((4 + (b) * 2 + (h)) * HTB)
#define PG8_STAGE(bufoff, gbase, voff) do { _Pragma("unroll") for (int _i = 0; _i < 2; ++_i) \
        __builtin_amdgcn_global_load_lds((const unsigned*)((const char*)(gbase) + (voff)[_i]), (PG8_LAS unsigned*)(lds + (bufoff) + ldsw + _i * 8192), 16, 0, 0); } while (0)
#define PG8_LDA(dst, b, h) do { _Pragma("unroll") for (int m = 0; m < 4; ++m) _Pragma("unroll") for (int k = 0; k < 2; ++k) dst[m][k] = *(const PG8_LAS bf16x8*)(lds + PG8_SA(b, h) + aoff + m * 2048 + k * 1024); } while (0)
#define PG8_LDB(dst, b, h) do { _Pragma("unroll") for (int n = 0; n < 2; ++n) _Pragma("unroll") for (int k = 0; k < 2; ++k) dst[n][k] = *(const PG8_LAS bf16x8*)(lds + PG8_SB(b, h) + boff + n * 2048 + k * 1024); } while (0)
#define PG8_MMA(ai, bj, At, Bt) do { __builtin_amdgcn_s_setprio(1); _Pragma("unroll") for (int m = 0; m < 4; ++m) _Pragma("unroll") for (int n = 0; n < 2; ++n) _Pragma("unroll") for (int k = 0; k < 2; ++k) \
        acc[ai][bj][m][n] = __builtin_amdgcn_mfma_f32_16x16x32_bf16(Bt[n][k], At[m][k], acc[ai][bj][m][n], 0, 0, 0); __builtin_amdgcn_s_setprio(0); } while (0)
#define PG8_WAIT_V(n) asm volatile("s_waitcnt vmcnt(" #n ")" ::: "memory")
#define PG8_WAIT_L(n) asm volatile("s_waitcnt lgkmcnt(" #n ")" ::: "memory")
#define PG8_BAR __builtin_amdgcn_s_barrier()
#define PG8_SCHED __builtin_amdgcn_sched_barrier(0)
    Unit cur, nxt; int ui = 0;
    if (!S.next(0, cur)) return;
    f32x4 acc[2][2][4][2];
#pragma unroll
    for (int a = 0; a < 2; ++a)
#pragma unroll
        for (int b = 0; b < 2; ++b)
#pragma unroll
            for (int m = 0; m < 4; ++m)
#pragma unroll
                for (int n = 0; n < 2; ++n) acc[a][b][m][n] = (f32x4){0.f, 0.f, 0.f, 0.f};
    bf16x8 At[4][2], B0[2][2], B1[2][2];
    const char* cA = (const char*)g.A + (size_t)cur.pm * tstep + (size_t)cur.ks * K * 2; const char* cB = (const char*)g.Bt + (size_t)cur.pn * tstep + (size_t)cur.ks * K * 2;
    S.a_ready(cur);
    if constexpr (SP2) {
        PG8_STAGE(PG8_SB(0, 0), cB, voffB); PG8_STAGE(PG8_SB(0, 1), cB + hstep, voffB); PG8_STAGE(PG8_SA(0, 0), cA, voffA); PG8_STAGE(PG8_SA(0, 1), cA + hstep, voffA);
        if (wr == 1) PG8_BAR;
        PG8_WAIT_V(2); PG8_BAR;
        PG8_STAGE(PG8_SB(1, 0), cB + kstep, voffB); PG8_STAGE(PG8_SA(1, 0), cA + kstep, voffA); PG8_STAGE(PG8_SB(1, 1), cB + hstep + kstep, voffB);
        PG8_WAIT_V(6); PG8_BAR;
    } else {
        PG8_STAGE(PG8_SB(0, 0), cB, voffB); PG8_STAGE(PG8_SA(0, 0), cA, voffA); PG8_STAGE(PG8_SB(0, 1), cB + hstep, voffB); PG8_STAGE(PG8_SA(0, 1), cA + hstep, voffA);
        if (wr == 1) PG8_BAR;
        PG8_WAIT_V(4); PG8_BAR;
        PG8_STAGE(PG8_SB(1, 0), cB + kstep, voffB); PG8_STAGE(PG8_SA(1, 0), cA + kstep, voffA); PG8_STAGE(PG8_SB(1, 1), cB + hstep + kstep, voffB);
        PG8_WAIT_V(6); PG8_BAR;
    }
    for (;;) {
        const bool has_next = S.next(ui + 1, nxt);
        const char* nA = has_next ? (const char*)g.A + (size_t)nxt.pm * tstep + (size_t)nxt.ks * K * 2 : cA; const char* nB = has_next ? (const char*)g.Bt + (size_t)nxt.pn * tstep + (size_t)nxt.ks * K * 2 : cB;
_Pragma("unroll 1")
        for (int t = 0; t < nt; t += 2) {
            const bool last = (t == nt - 2);
            const char* a1 = cA + (size_t)(t + 1) * kstep;
            const char* a2 = last ? nA : cA + (size_t)(t + 2) * kstep; const char* b2 = last ? nB : cB + (size_t)(t + 2) * kstep;
            const char* a3 = a2 + kstep; const char* b3 = b2 + kstep;
            if (last && has_next) S.a_ready(nxt);
            if constexpr (SP2) {
            PG8_LDB(B0, 0, 0); PG8_LDB(B1, 0, 1); PG8_SCHED; PG8_LDA(At, 0, 0); PG8_STAGE(PG8_SA(1, 1), a1 + hstep, voffA);
            PG8_WAIT_V(8); PG8_WAIT_L(0); PG8_BAR; PG8_MMA(0, 0, At, B0); PG8_MMA(0, 1, At, B1); PG8_BAR; PG8_SCHED;
            PG8_LDA(At, 0, 1); PG8_STAGE(PG8_SB(0, 0), b2, voffB); PG8_STAGE(PG8_SB(0, 1), b2 + hstep, voffB); PG8_STAGE(PG8_SA(0, 0), a2, voffA);
            PG8_WAIT_V(8); PG8_WAIT_L(0); PG8_BAR; PG8_MMA(1, 0, At, B0); PG8_MMA(1, 1, At, B1); PG8_BAR; PG8_SCHED;
            PG8_LDB(B0, 1, 0); PG8_LDB(B1, 1, 1); PG8_SCHED; PG8_LDA(At, 1, 0); PG8_STAGE(PG8_SA(0, 1), a2 + hstep, voffA);
            PG8_WAIT_V(8); PG8_WAIT_L(0); PG8_BAR; PG8_MMA(0, 0, At, B0); PG8_MMA(0, 1, At, B1); PG8_BAR; PG8_SCHED;
            PG8_LDA(At, 1, 1); PG8_STAGE(PG8_SB(1, 0), b3, voffB); PG8_STAGE(PG8_SB(1, 1), b3 + hstep, voffB); PG8_STAGE(PG8_SA(1, 0), a3, voffA);
            PG8_WAIT_V(8); PG8_WAIT_L(0); PG8_BAR; PG8_MMA(1, 0, At, B0); PG8_MMA(1, 1, At, B1); PG8_BAR; PG8_SCHED;
            } else {
            PG8_LDB(B0, 0, 0); PG8_SCHED; PG8_LDA(At, 0, 0); PG8_STAGE(PG8_SA(1, 1), a1 + hstep, voffA);
            PG8_WAIT_L(8); PG8_BAR; PG8_WAIT_L(0); PG8_MMA(0, 0, At, B0); PG8_BAR; PG8_SCHED;
            PG8_LDB(B1, 0, 1); PG8_STAGE(PG8_SB(0, 0), b2, voffB);
            PG8_BAR; PG8_WAIT_L(0); PG8_MMA(0, 1, At, B1); PG8_BAR;
            PG8_LDA(At, 0, 1); PG8_STAGE(PG8_SA(0, 0), a2, voffA);
            PG8_BAR; PG8_WAIT_L(0); PG8_MMA(1, 0, At, B0); PG8_BAR; PG8_SCHED;
            PG8_STAGE(PG8_SB(0, 1), b2 + hstep, voffB);
            PG8_WAIT_V(6); PG8_BAR; PG8_MMA(1, 1, At, B1); PG8_BAR;
            PG8_LDB(B0, 1, 0); PG8_SCHED; PG8_LDA(At, 1, 0); PG8_STAGE(PG8_SA(0, 1), a2 + hstep, voffA);
            PG8_WAIT_L(8); PG8_BAR; PG8_WAIT_L(0); PG8_MMA(0, 0, At, B0); PG8_BAR; PG8_SCHED;
            PG8_LDB(B1, 1, 1); PG8_STAGE(PG8_SB(1, 0), b3, voffB);
            PG8_BAR; PG8_WAIT_L(0); PG8_MMA(0, 1, At, B1); PG8_BAR;
            PG8_LDA(At, 1, 1); PG8_STAGE(PG8_SA(1, 0), a3, voffA);
            PG8_BAR; PG8_WAIT_L(0); PG8_MMA(1, 0, At, B0); PG8_BAR; PG8_SCHED;
            PG8_STAGE(PG8_SB(1, 1), b3 + hstep, voffB);
            PG8_WAIT_V(6); PG8_BAR; PG8_MMA(1, 1, At, B1); PG8_BAR;
            }
        }
        if constexpr (ALIGN_EPI) { if (wr == 0) PG8_BAR; }
        if constexpr (!Epi::AFTER_DRAIN) { E(acc, cur, wr, wc, fr, fq); S.done(cur); }
        if (!has_next) break;
#pragma unroll
        for (int a = 0; a < 2; ++a)
#pragma unroll
            for (int b = 0; b < 2; ++b)
#pragma unroll
                for (int m = 0; m < 4; ++m)
#pragma unroll
                    for (int n = 0; n < 2; ++n) acc[a][b][m][n] = (f32x4){0.f, 0.f, 0.f, 0.f};
        cur = nxt; cA = nA; cB = nB; ++ui;
        if constexpr (ALIGN_EPI) { if (wr == 1) PG8_BAR; }
    }
    PG8_WAIT_V(0);
    if constexpr (!ALIGN_EPI) { if (wr == 0) PG8_BAR; }
    PG8_BAR;
    if constexpr (Epi::AFTER_DRAIN) { E.fused(acc, cur, wr, wc, fr, fq, lds, wid, lane); S.done(cur); }
#undef PG8_SA
#undef PG8_SB
#undef PG8_STAGE
#undef PG8_LDA
#undef PG8_LDB
#undef PG8_MMA
#undef PG8_WAIT_V
#undef PG8_WAIT_L
#undef PG8_BAR
#undef PG8_SCHED
}
}

#ifndef PG8_SP2
#define PG8_SP2 true
#endif
#ifndef PG8_ALIGN
#define PG8_ALIGN true
#endif
#include <hip/hip_bf16.h>
#include <cmath>
namespace attn_body {
using bf16=__hip_bfloat16;
using bf16x8=__attribute__((ext_vector_type(8)))short;
using s16x4=__attribute__((ext_vector_type(4)))short;
using f32x16=__attribute__((ext_vector_type(16)))float;
using u32x4=__attribute__((ext_vector_type(4)))unsigned;
constexpr int BATCH=2,NHEAD=8,SEQ=8192,D=64,DQK=96,DM=NHEAD*D,QPITCH=NHEAD*DQK,KRP=32;
constexpr int NW=8,QBLK=32,QB=QBLK*NW,KVBLK=64,NQB=SEQ/QB;
constexpr int ATTN_PITCH=DM, ATTN_UNIT_ROWS=QB;
__device__ __forceinline__ int crow(int r,int hi){return (r&3)+8*(r>>2)+4*hi;}
__device__ __forceinline__ f32x16 splat16(float v){return (f32x16){v,v,v,v,v,v,v,v,v,v,v,v,v,v,v,v};}
#define SBAR() __builtin_amdgcn_sched_barrier(0)
__device__ __forceinline__ void cmask(f32x16&p0,f32x16&p1,int jb,int qrel,int hi){
  const float NEG=-INFINITY; int kb=64*jb+4*hi;
  #pragma unroll
  for(int r=0;r<16;++r){int kv=kb+(r&3)+8*(r>>2); if(kv>qrel)p0[r]=NEG; if(kv+32>qrel)p1[r]=NEG;}
}

constexpr int NSLOT=3, SLOTB=8192, KSLOTB=12288;
constexpr int LDS_K=0, LDS_V=NSLOT*KSLOTB, LDS_WS=LDS_V+NSLOT*SLOTB, LDS_OST=LDS_WS+NW*64*4, LDS_BYTES=LDS_OST+NW*4096;
constexpr float C2=0.10206207261596575f*1.4426950408889634f;
__device__ __forceinline__ void glds16(const void*gsrc,unsigned lds_dst){unsigned keep;
  asm volatile("s_mov_b32 %0, m0\n\ts_mov_b32 m0, %2\n\ts_nop 0\n\tglobal_load_lds_dwordx4 %1, off\n\ts_mov_b32 m0, %0":"=&s"(keep):"v"(gsrc),"s"(lds_dst):"memory");}
__device__ __forceinline__ float max3f(float a,float b,float c){float r;asm("v_max3_f32 %0, %1, %2, %3":"=v"(r):"v"(a),"v"(b),"v"(c));return r;}
__device__ __forceinline__ float max2f(float a,float b){float r;asm("v_max_f32_e32 %0, %1, %2":"=v"(r):"v"(a),"v"(b));return r;}
__device__ __forceinline__ float fadd_s(float a,float b){float r;asm("v_add_f32_e32 %0, %1, %2":"=v"(r):"v"(a),"v"(b));return r;}
__device__ __forceinline__ float fsub_s(float a,float b){float r;asm("v_sub_f32_e32 %0, %1, %2":"=v"(r):"v"(a),"v"(b));return r;}
typedef float f32x2_t __attribute__((ext_vector_type(2))); typedef __bf16 bf16x2_t __attribute__((ext_vector_type(2)));
__device__ __forceinline__ unsigned cvtpk_s(float lo,float hi){f32x2_t v={lo,hi};bf16x2_t b=__builtin_convertvector(v,bf16x2_t);return __builtin_bit_cast(unsigned,b);}
#define WAIT_BAR(N) asm volatile("s_waitcnt vmcnt(" #N ") lgkmcnt(0)\n\ts_barrier":::"memory")

__device__ __forceinline__ void qkt(f32x16&p0,f32x16&p1,const char*Kslot,const bf16x8*qr,const f32x16&negm,int r32,int hi){
  const char*kb=Kslot+hi*1024+r32*16;
  #pragma unroll
  for(int d0=0;d0<6;++d0){
    const bf16x8 b0=*reinterpret_cast<const bf16x8*>(kb+d0*2048);
    const bf16x8 b1=*reinterpret_cast<const bf16x8*>(kb+d0*2048+512);
    if(d0==0){p0=__builtin_amdgcn_mfma_f32_32x32x16_bf16(b0,qr[0],negm,0,0,0);p1=__builtin_amdgcn_mfma_f32_32x32x16_bf16(b1,qr[0],negm,0,0,0);}
    else{p0=__builtin_amdgcn_mfma_f32_32x32x16_bf16(b0,qr[d0],p0,0,0,0);p1=__builtin_amdgcn_mfma_f32_32x32x16_bf16(b1,qr[d0],p1,0,0,0);}}
}
typedef __attribute__((address_space(3))) const char* lds_cptr;
typedef short v4i16_t __attribute__((ext_vector_type(4)));
__device__ __forceinline__ void kload8(bf16x8*kf,lds_cptr kp){
  kf[0]=*(const __attribute__((address_space(3))) bf16x8*)(kp);      kf[1]=*(const __attribute__((address_space(3))) bf16x8*)(kp+512);
  kf[2]=*(const __attribute__((address_space(3))) bf16x8*)(kp+2048); kf[3]=*(const __attribute__((address_space(3))) bf16x8*)(kp+2560);
  kf[4]=*(const __attribute__((address_space(3))) bf16x8*)(kp+4096); kf[5]=*(const __attribute__((address_space(3))) bf16x8*)(kp+4608);
  kf[6]=*(const __attribute__((address_space(3))) bf16x8*)(kp+6144); kf[7]=*(const __attribute__((address_space(3))) bf16x8*)(kp+6656);
  kf[8]=*(const __attribute__((address_space(3))) bf16x8*)(kp+8192); kf[9]=*(const __attribute__((address_space(3))) bf16x8*)(kp+8704);
  kf[10]=*(const __attribute__((address_space(3))) bf16x8*)(kp+10240); kf[11]=*(const __attribute__((address_space(3))) bf16x8*)(kp+10752);
}
__device__ __forceinline__ void kload2(bf16x8*kf,lds_cptr kp,int j){ kf[2*j]=*(const __attribute__((address_space(3))) bf16x8*)(kp+j*2048); kf[2*j+1]=*(const __attribute__((address_space(3))) bf16x8*)(kp+j*2048+512); }
__device__ __forceinline__ s16x4 vtr(lds_cptr p){ return __builtin_bit_cast(s16x4,__builtin_amdgcn_ds_read_tr16_b64_v4i16((__attribute__((address_space(3))) v4i16_t*)p)); }
__device__ __forceinline__ float rowmax(const f32x16&p0,const f32x16&p1){
  float a=max3f(p0[0],p0[1],p1[0]),b=max3f(p0[2],p0[3],p1[1]);a=max3f(a,p1[2],p1[3]);
  #pragma unroll
  for(int r=4;r<16;r+=4){a=max3f(a,p0[r],p0[r+1]);b=max3f(b,p0[r+2],p0[r+3]);a=max3f(a,p1[r],p1[r+1]);b=max3f(b,p1[r+2],p1[r+3]);}
  const float m=max2f(a,b);
  auto rr=__builtin_amdgcn_permlane32_swap(__float_as_uint(m),__float_as_uint(m),false,false);
  return max2f(__uint_as_float(rr[0]),__uint_as_float(rr[1]));
}
__device__ __forceinline__ void pv(f32x16*o,int vb,bf16x8 pa0,bf16x8 pa1,bf16x8 pa2,bf16x8 pa3){
  #pragma unroll
  for(int d0=0;d0<2;++d0){s16x4 lo[4],hi[4];
    #pragma unroll
    for(int ks=0;ks<4;++ks){
      asm volatile("ds_read_b64_tr_b16 %0,%1 offset:%c2":"=&v"(lo[ks]):"v"(vb),"i"(d0*4096+ks*1024):"memory");
      asm volatile("ds_read_b64_tr_b16 %0,%1 offset:%c2":"=&v"(hi[ks]):"v"(vb),"i"(d0*4096+ks*1024+512):"memory");}
    asm volatile("s_waitcnt lgkmcnt(0)":::"memory");SBAR();
    #define PK(k) (bf16x8){lo[k][0],lo[k][1],lo[k][2],lo[k][3],hi[k][0],hi[k][1],hi[k][2],hi[k][3]}
    o[d0]=__builtin_amdgcn_mfma_f32_32x32x16_bf16(pa0,PK(0),o[d0],0,0,0);
    o[d0]=__builtin_amdgcn_mfma_f32_32x32x16_bf16(pa1,PK(1),o[d0],0,0,0);
    o[d0]=__builtin_amdgcn_mfma_f32_32x32x16_bf16(pa2,PK(2),o[d0],0,0,0);
    o[d0]=__builtin_amdgcn_mfma_f32_32x32x16_bf16(pa3,PK(3),o[d0],0,0,0);
    #undef PK
  }
}

#ifndef ATTN_STORE16
#define ATTN_STORE16(p,v) (*(u32x4*)(p)=(v))
#endif
template<int THRL> __device__ __forceinline__ void attn_unit(int b,int h,int qb,const bf16*Q,const bf16*__restrict__ K,const bf16*__restrict__ KR,const bf16*__restrict__ V,bf16*O,char*shm,int wid_s){
  const int wid=wid_s,lane=lane_now(),tid=wid*64+lane,r32=lane&31,hi=lane>>5; (void)tid;
  const long rowbase=(long)b*SEQ; const int q0=qb*QB;
  const bf16*Qw=Q+(rowbase+q0+wid*QBLK)*QPITCH+h*DQK;
  const bf16*Kh=K+rowbase*DM+h*D,*Vh=V+rowbase*DM+h*D;
  const unsigned lds0=(unsigned)(uintptr_t)shm;
  float*wsf=(float*)(shm+LDS_WS)+wid*64;
  const bf16*ksrc=Kh+(long)lane*DM+wid*8;
  const bf16*krsrc=KR+(rowbase+32*(wid&1)+(lane&31))*KRP+(wid>>1)*8;
  const bf16*vsrc=Vh+(long)(16*(wid&3)+(lane>>2))*DM+(wid>>2)*32+(lane&3)*8;
  const unsigned kdst=lds0+LDS_K+wid*1024, vdst=lds0+LDS_V+wid*1024, krdst=lds0+LDS_K+(8+(wid>>1))*1024+(wid&1)*512;
  #define DMA_K(t,slot) do{ glds16(ksrc+(long)(t)*KVBLK*DM,(unsigned)__builtin_amdgcn_readfirstlane(kdst+(slot))); if(lane<32){ glds16(krsrc+(long)(t)*KVBLK*KRP,(unsigned)__builtin_amdgcn_readfirstlane(krdst+(slot))); } }while(0)
  #define DMA_V(t,slot) glds16(vsrc+(long)(t)*KVBLK*DM,(unsigned)__builtin_amdgcn_readfirstlane(vdst+(slot)))
  const int vb0=(int)(lds0+LDS_V)+((lane>>4)&1)*32+(lane&3)*8+(4*hi+((lane&15)>>2))*64;
  const char*Kbase=shm+LDS_K; bf16x8 kf[12];
  const lds_cptr shm3=(lds_cptr)shm; const lds_cptr kp0=shm3+LDS_K+hi*1024+r32*16; const lds_cptr vp0=shm3+LDS_V+((lane>>4)&1)*32+(lane&3)*8+(4*hi+((lane&15)>>2))*64;
  const int NT=(q0+QB)/KVBLK;
  DMA_K(0,0);DMA_V(0,0);DMA_K(1,KSLOTB);
  bf16x8 qr[6];
  #pragma unroll
  for(int d0=0;d0<6;++d0)qr[d0]=*reinterpret_cast<const bf16x8*>(&Qw[(long)r32*QPITCH+d0*16+hi*8]);
  float mhat=0.f,l_reg=0.f;f32x16 o[2];o[0]=f32x16{};o[1]=f32x16{};
  const int qrel=wid*QBLK+r32;
  #define CMASK(P0,P1,t) do{int jb_=(t)-(NT-4); if(jb_>=0)cmask(P0,P1,jb_,qrel,hi);}while(0)
  bool resc=false;
  #define START(P0,P1) do{ const float rm=rowmax(P0,P1); resc=false; \
    { const float dl=rm; mhat=fadd_s(mhat,dl); \
      _Pragma("unroll") for(int r=0;r<16;++r){P0[r]=fsub_s(P0[r],dl);P1[r]=fsub_s(P1[r],dl);} \
      } \
    _Pragma("unroll") for(int r=0;r<16;++r)P0[r]=__builtin_amdgcn_exp2f(P0[r]); }while(0)
  #define RESC() do{ if(resc){ asm volatile("s_waitcnt lgkmcnt(0)":::"memory"); \
      _Pragma("unroll") for(int d_=0;d_<2;++d_) _Pragma("unroll") for(int r=0;r<16;++r)o[d_][r]*=wsf[crow(r,hi)]; } }while(0)
  f32x16 pA0,pA1,pB0,pB1;
  int sl_prev=0,sl_cur=0,sl_next=SLOTB;
  int ks_cur=0,ks_next=KSLOTB;
  #define ROT() do{sl_prev=sl_cur;sl_cur=sl_next;sl_next=(sl_next==(NSLOT-1)*SLOTB)?0:sl_next+SLOTB; ks_cur=ks_next;ks_next=(ks_next==(NSLOT-1)*KSLOTB)?0:ks_next+KSLOTB;}while(0)
  DMA_K(2,2*KSLOTB);
  WAIT_BAR(5);
  qkt(pA0,pA1,Kbase,qr,f32x16{},r32,hi);asm volatile("s_nop 15\n\ts_nop 7":"+v"(pA0),"+v"(pA1));CMASK(pA0,pA1,0);
  START(pA0,pA1);
  _Pragma("unroll") for(int r=0;r<16;++r)pA1[r]=__builtin_amdgcn_exp2f(pA1[r]);
  WAIT_BAR(0);
  DMA_K(3,0);DMA_V(1,SLOTB);
  ROT();
  kload8(kf,kp0+ks_cur);
  WAIT_BAR(3);
  s16x4 vlo[8],vhi[8]; u32x4 pw0,pw1,pw2,pw3;
  #define PKW(P,B) cvtpk_s(P[B],P[B+1])
  #define PAF(k) __builtin_bit_cast(bf16x8,pw##k)
  #define VFR(i) (bf16x8){vlo[i][0],vlo[i][1],vlo[i][2],vlo[i][3],vhi[i][0],vhi[i][1],vhi[i][2],vhi[i][3]}
  #define PIN(x) asm volatile("":"+v"(x))
  #define MX3(a,b,c) __builtin_fmaxf(__builtin_fmaxf((a),(b)),(c))
  #define GAPA(MF,A0,A1,A2,A3,W0,W1,PW) do{ MF; sacc+=A0; sacc+=A1; sacc+=A2; sacc+=A3; PIN(sacc); W0; W1; PIN(PW); SBAR(); }while(0)
  #define EX(v) __builtin_amdgcn_exp2f(v)
  #define GAPB(MF,X,B) do{ MF; X[B]=EX(X[B]); X[B+1]=EX(X[B+1]); X[B+2]=EX(X[B+2]); X[B+3]=EX(X[B+3]); PIN(X); SBAR(); }while(0)
  #define VRD(i) do{ vlo[i]=vtr(vp_+(((i)>>2)*4096+((i)&3)*1024)); vhi[i]=vtr(vp_+(((i)>>2)*4096+((i)&3)*1024+512)); }while(0)
  #define KRD(G,j) do{ if(G){ kload2(kf,kp0+ks_next,j); SBAR(); } }while(0)
  #define NEGM() splat16(-mhat)
  #define STEP(C0,C1,P0,P1,t,GK,GV,GL) do{ SBAR(); \
    const lds_cptr vp_=vp0+sl_prev; \
    float sacc=(P0[0]+P0[1]); \
    GAPA(C0=__builtin_amdgcn_mfma_f32_32x32x16_bf16(kf[0],qr[0],NEGM(),0,0,0), P0[2],P0[3],P0[4],P0[5],     pw0[0]=PKW(P0,0), pw0[1]=PKW(P0,2), pw0); \
    GAPA(C1=__builtin_amdgcn_mfma_f32_32x32x16_bf16(kf[1],qr[0],NEGM(),0,0,0), P0[6],P0[7],P0[8],P0[9],     pw0[2]=PKW(P0,4), pw0[3]=PKW(P0,6), pw0); \
    GAPA(C0=__builtin_amdgcn_mfma_f32_32x32x16_bf16(kf[2],qr[1],C0,0,0,0),   P0[10],P0[11],P0[12],P0[13], pw1[0]=PKW(P0,8), pw1[1]=PKW(P0,10), pw1); \
    GAPA(C1=__builtin_amdgcn_mfma_f32_32x32x16_bf16(kf[3],qr[1],C1,0,0,0),   P0[14],P0[15],P1[0],P1[1],   pw1[2]=PKW(P0,12),pw1[3]=PKW(P0,14), pw1); \
    VRD(0); SBAR(); GAPA(C0=__builtin_amdgcn_mfma_f32_32x32x16_bf16(kf[4],qr[2],C0,0,0,0),   P1[2],P1[3],P1[4],P1[5],     pw2[0]=PKW(P1,0), pw2[1]=PKW(P1,2), pw2); \
    VRD(4); SBAR(); GAPA(C1=__builtin_amdgcn_mfma_f32_32x32x16_bf16(kf[5],qr[2],C1,0,0,0),   P1[6],P1[7],P1[8],P1[9],     pw2[2]=PKW(P1,4), pw2[3]=PKW(P1,6), pw2); \
    VRD(1); SBAR(); GAPA(C0=__builtin_amdgcn_mfma_f32_32x32x16_bf16(kf[6],qr[3],C0,0,0,0),   P1[10],P1[11],P1[12],P1[13], pw3[0]=PKW(P1,8), pw3[1]=PKW(P1,10), pw3); \
    VRD(5); SBAR(); GAPA(C1=__builtin_amdgcn_mfma_f32_32x32x16_bf16(kf[7],qr[3],C1,0,0,0),   P1[14],P1[15],0.f,0.f,       pw3[2]=PKW(P1,12),pw3[3]=PKW(P1,14), pw3); \
    VRD(2); SBAR(); C0=__builtin_amdgcn_mfma_f32_32x32x16_bf16(kf[8],qr[4],C0,0,0,0); SBAR(); \
    VRD(6); SBAR(); C1=__builtin_amdgcn_mfma_f32_32x32x16_bf16(kf[9],qr[4],C1,0,0,0); SBAR(); \
    VRD(3); SBAR(); C0=__builtin_amdgcn_mfma_f32_32x32x16_bf16(kf[10],qr[5],C0,0,0,0); SBAR(); \
    VRD(7); SBAR(); C1=__builtin_amdgcn_mfma_f32_32x32x16_bf16(kf[11],qr[5],C1,0,0,0); SBAR(); \
    l_reg+=sacc; \
    if(GK){DMA_K((t)+3,ks_cur);} if(GV){DMA_V((t)+1,sl_next);} \
    CMASK(C0,C1,t); \
    { float a=MX3(C0[0],C0[1],C1[0]),b=MX3(C0[2],C0[3],C1[1]); a=MX3(a,C1[2],C1[3]); \
      _Pragma("unroll") for(int r=4;r<16;r+=4){a=MX3(a,C0[r],C0[r+1]);b=MX3(b,C0[r+2],C0[r+3]);a=MX3(a,C1[r],C1[r+1]);b=MX3(b,C1[r+2],C1[r+3]);} \
      float rm=__builtin_fmaxf(a,b); { auto rr=__builtin_amdgcn_permlane32_swap(__float_as_uint(rm),__float_as_uint(rm),false,false); rm=__builtin_fmaxf(__uint_as_float(rr[0]),__uint_as_float(rr[1])); } \
      resc=false; \
      if(__builtin_expect(__any(rm>(float)THRL),0)){ const float dl=__builtin_fmaxf(rm,0.f); mhat+=dl; \
        _Pragma("unroll") for(int r=0;r<16;++r){C0[r]-=dl;C1[r]-=dl;} \
        const float f=__builtin_amdgcn_exp2f(-dl); l_reg*=f; if(hi==0){ int r32o_=r32; asm volatile("":"+v"(r32o_)); wsf[r32o_]=f; } resc=true; } } \
    SBAR(); \
    GAPB(o[0]=__builtin_amdgcn_mfma_f32_32x32x16_bf16(PAF(0),VFR(0),o[0],0,0,0), C0,0); \
    KRD(GL,0); GAPB(o[1]=__builtin_amdgcn_mfma_f32_32x32x16_bf16(PAF(0),VFR(4),o[1],0,0,0), C0,4); \
    KRD(GL,1); GAPB(o[0]=__builtin_amdgcn_mfma_f32_32x32x16_bf16(PAF(1),VFR(1),o[0],0,0,0), C0,8); \
    KRD(GL,2); GAPB(o[1]=__builtin_amdgcn_mfma_f32_32x32x16_bf16(PAF(1),VFR(5),o[1],0,0,0), C0,12); \
    KRD(GL,3); GAPB(o[0]=__builtin_amdgcn_mfma_f32_32x32x16_bf16(PAF(2),VFR(2),o[0],0,0,0), C1,0); \
    KRD(GL,4); GAPB(o[1]=__builtin_amdgcn_mfma_f32_32x32x16_bf16(PAF(2),VFR(6),o[1],0,0,0), C1,4); \
    KRD(GL,5); GAPB(o[0]=__builtin_amdgcn_mfma_f32_32x32x16_bf16(PAF(3),VFR(3),o[0],0,0,0), C1,8); \
    GAPB(o[1]=__builtin_amdgcn_mfma_f32_32x32x16_bf16(PAF(3),VFR(7),o[1],0,0,0), C1,12); \
    }while(0)
  int t=1;
  #undef CMASK
  #define CMASK(P0,P1,t) do{}while(0)
  for(;t+5<NT;t+=2){
    STEP(pB0,pB1,pA0,pA1,t,true,true,true);     WAIT_BAR(3); RESC(); ROT();
    STEP(pA0,pA1,pB0,pB1,t+1,true,true,true);   WAIT_BAR(3); RESC(); ROT();
  }
  #undef CMASK
  #define CMASK(P0,P1,t) do{int jb_=(t)-(NT-4); if(jb_>=0)cmask(P0,P1,jb_,qrel,hi);}while(0)
  #define ENDW(tt) do{ if((tt)+3<NT){WAIT_BAR(3);} else if((tt)+2<NT){WAIT_BAR(1);} else {WAIT_BAR(0);} }while(0)
  for(;t+1<NT;t+=2){
    STEP(pB0,pB1,pA0,pA1,t,(t+3<NT),(t+1<NT),(t+1<NT));       ENDW(t);   RESC(); ROT();
    STEP(pA0,pA1,pB0,pB1,t+1,(t+4<NT),(t+2<NT),(t+2<NT));     ENDW(t+1); RESC(); ROT();
  }
  STEP(pB0,pB1,pA0,pA1,NT-1,false,false,false); RESC();
  { float sacc=pB0[0]+pB0[1]; _Pragma("unroll") for(int r=2;r<16;++r)sacc+=pB0[r]; _Pragma("unroll") for(int r=0;r<16;++r)sacc+=pB1[r]; l_reg+=sacc;
    pw0=(u32x4){PKW(pB0,0),PKW(pB0,2),PKW(pB0,4),PKW(pB0,6)};pw1=(u32x4){PKW(pB0,8),PKW(pB0,10),PKW(pB0,12),PKW(pB0,14)};pw2=(u32x4){PKW(pB1,0),PKW(pB1,2),PKW(pB1,4),PKW(pB1,6)};pw3=(u32x4){PKW(pB1,8),PKW(pB1,10),PKW(pB1,12),PKW(pB1,14)};
    SBAR(); pv(o,vb0+sl_cur,PAF(0),PAF(1),PAF(2),PAF(3)); }
  #undef PKW
  #undef PAF
  #undef VFR
  #undef PIN
  #undef MX3
  #undef GAPA
  #undef GAPB
  #undef EX
  #undef VRD
  #undef KRD
  #undef STEP
  #undef ENDW
  {auto rr=__builtin_amdgcn_permlane32_swap(__float_as_uint(l_reg),__float_as_uint(l_reg),false,false);l_reg=__uint_as_float(rr[0])+__uint_as_float(rr[1]);}
  if(hi==0)wsf[32+r32]=l_reg;asm volatile("s_waitcnt lgkmcnt(0)":::"memory");
  float rli[16];
  #pragma unroll
  for(int r=0;r<16;++r)rli[r]=__builtin_amdgcn_rcpf(wsf[32+crow(r,hi)]);
  bf16*Ow=O+(rowbase+q0+wid*QBLK)*DM+h*D;
  { bf16*stg=(bf16*)(shm+LDS_OST)+wid*2048;
    #pragma unroll
    for(int r=0;r<16;++r){const int orow=crow(r,hi);
      #pragma unroll
      for(int d0=0;d0<2;++d0)stg[orow*64+d0*32+r32]=__float2bfloat16(o[d0][r]*rli[r]);}
    asm volatile("s_waitcnt lgkmcnt(0)":::"memory");
    #pragma unroll
    for(int i=0;i<4;++i){const int row=i*8+(lane>>3),ch=lane&7; const u32x4 v=*(const u32x4*)(stg+row*64+ch*8); ATTN_STORE16(Ow+(long)row*DM+ch*8,v);} }
  asm volatile("s_waitcnt lgkmcnt(0)\n\ts_barrier":::"memory");
  #undef DMA_K
  #undef DMA_V
  #undef CMASK
  #undef START
  #undef RESC
  #undef ROT
}
constexpr int ATTN_LDS_BYTES=LDS_BYTES;
struct AttnTensors { const bf16* Q; const bf16* K; const bf16* KR; const bf16* V; bf16* O; };
struct AttnUnit { int bh; int qb; };
struct StaticOrder {
  int vcu;
  __device__ __forceinline__ explicit StaticOrder(int grid,int block):vcu((block%8)*(grid/8)+block/8){}
  __device__ __forceinline__ bool next(int i,AttnUnit&u)const{ if(i>=2)return false; const int s=vcu&15; u.bh=vcu>>4; u.qb=(i==0)?s:31-s; return true; }
  __device__ __forceinline__ void a_ready(const AttnUnit&)const{}
  __device__ __forceinline__ void done(const AttnUnit&)const{}
};
template<class Sched,int THRL=8> __device__ __forceinline__ void attn_phase(char*lds,const AttnTensors&T,const Sched&S,int wid_s){
  AttnUnit u;
  for(int i=0;S.next(i,u);++i){ S.a_ready(u); attn_unit<THRL>(u.bh/NHEAD,u.bh%NHEAD,u.qb,T.Q,T.K,T.KR,T.V,T.O,lds,wid_s); S.done(u); }
}
#undef SBAR
#undef WAIT_BAR
}
#define GAS __attribute__((address_space(1)))
#define LAS __attribute__((address_space(3)))
typedef unsigned short bf16;
typedef unsigned v4u __attribute__((ext_vector_type(4)));
typedef float f32x4 __attribute__((ext_vector_type(4)));
typedef short bf16x8 __attribute__((ext_vector_type(8)));
typedef GAS unsigned gu32;
typedef GAS unsigned long long gu64;
#define RLX_AGENT __ATOMIC_RELAXED, __HIP_MEMORY_SCOPE_AGENT
#define LDS_WAIT() asm volatile("s_waitcnt lgkmcnt(0)" ::: "memory")
#define VM_WAIT() asm volatile("s_waitcnt vmcnt(0)" ::: "memory")
__device__ __forceinline__ unsigned long long rt() { return __builtin_amdgcn_s_memrealtime(); }
__device__ __forceinline__ unsigned f2bf(float f) { unsigned u = __builtin_bit_cast(unsigned, f); return (u + 0x7fffu + ((u >> 16) & 1u)) >> 16; }
__device__ __forceinline__ unsigned pk2(float lo, float hi) { return f2bf(lo) | (f2bf(hi) << 16); }

#define XB_TMO      128
#define XB_XCNT(j)  (256  + 64 * (j))
#define XB_XSUB(j)  (1280 + 64 * (j))
#define XB_XGEN(j)  (2304 + 64 * (j))
#define XB_TOP      3328
#define XB_TOPGEN   3392
#define XCD_BAR_WORDS 3456
#define XB_SPIN_CAP (1u << 18)

__device__ __forceinline__ unsigned xb_ld(unsigned* p)              { return __hip_atomic_load(p, __ATOMIC_RELAXED, __HIP_MEMORY_SCOPE_AGENT); }
__device__ __forceinline__ unsigned xb_add(unsigned* p, unsigned v) { return __hip_atomic_fetch_add(p, v, __ATOMIC_RELAXED, __HIP_MEMORY_SCOPE_AGENT); }
__device__ __forceinline__ unsigned xb_xcc_id() { return (unsigned)__builtin_amdgcn_s_getreg((3 << 11) | 20) & 0xFu; }
#define XB_SPIN(cond, bar) do { unsigned _sp = 0; while (cond) { __builtin_amdgcn_s_sleep(1); \
    if ((++_sp & 255u) == 0u) { if (xb_ld(&(bar)[XB_TMO])) break; if (_sp > XB_SPIN_CAP) { atomicAdd(&(bar)[XB_TMO], 1u); break; } } } } while (0)

struct XcdBarrier {
    unsigned* bar; unsigned x;
    volatile LAS unsigned* st;
};

__device__ __forceinline__ XcdBarrier xcd_barrier_post(unsigned* bar, volatile LAS unsigned* st, bool t0  ) {
    XcdBarrier b; b.bar = bar; b.x = xb_xcc_id(); b.st = st;
    if (t0) (void)xb_add(&bar[XB_XCNT(b.x)], 1u);
    return b;
}
__device__ __forceinline__ void xcd_barrier_complete(unsigned* bar, unsigned x, unsigned& nloc, unsigned& nx) {
    const unsigned G = gridDim.x * gridDim.y * gridDim.z;
    unsigned sum, cnt, mine, sp = 0u;
    for (;;) {
        sum = 0u; cnt = 0u; mine = 0u;
#pragma unroll
        for (unsigned j = 0; j < 16; ++j) { const unsigned c = xb_ld(&bar[XB_XCNT(j)]); sum += c; cnt += (c > 0u) ? 1u : 0u; mine = (j == x) ? c : mine; }
        if (sum == G) break;
        __builtin_amdgcn_s_sleep(1);
        if ((++sp & 255u) == 0u) { if (xb_ld(&bar[XB_TMO])) break; if (sp > XB_SPIN_CAP) { atomicAdd(&bar[XB_TMO], 1u); break; } }
    }
    nloc = mine > 0u ? mine : 1u; nx = cnt > 0u ? cnt : 1u;
}

__device__ __forceinline__ void xcd_barrier(const XcdBarrier& b, bool t0  ) {
    asm volatile("s_waitcnt vmcnt(0)" ::: "memory");
    __syncthreads();
    if (t0) {
        unsigned* bar = b.bar;
        __builtin_amdgcn_s_waitcnt(0);
        unsigned nloc = b.st[0], nx = b.st[1];
        if (nloc == 0u) { xcd_barrier_complete(bar, b.x, nloc, nx); b.st[0] = nloc; b.st[1] = nx; }
        const unsigned old = xb_add(&bar[XB_XSUB(b.x)], 1u);
        const unsigned gen = old / nloc;
        if (old + 1u == (gen + 1u) * nloc) {
            __builtin_amdgcn_fence(__ATOMIC_RELEASE, "agent");
            asm volatile("s_waitcnt vmcnt(0)" ::: "memory");
            const unsigned og = xb_add(&bar[XB_TOP], 1u);
            const unsigned tg = og / nx;
            if (og + 1u == (tg + 1u) * nx) xb_add(&bar[XB_TOPGEN], 1u);
            else XB_SPIN(xb_ld(&bar[XB_TOPGEN]) == tg, bar);
            __builtin_amdgcn_fence(__ATOMIC_ACQUIRE, "agent");
            xb_add(&bar[XB_XGEN(b.x)], 1u);
            asm volatile("s_waitcnt vmcnt(0)" ::: "memory");
        } else {
            XB_SPIN(xb_ld(&bar[XB_XGEN(b.x)]) == gen, bar);
            __builtin_amdgcn_fence(__ATOMIC_ACQUIRE, "agent");
            asm volatile("s_waitcnt vmcnt(0)" ::: "memory");
        }
    }
    __syncthreads();
}
constexpr int NWAVES = 8;
#ifndef MK_N_LAUNCHES
#define MK_N_LAUNCHES 1
#endif
constexpr int N_PHASES = 11;

constexpr int MP = 16384, MS = 1024, MT = MP + MS;
constexpr int DM = 1024, NZ = 1792, QRK = 384, NQ = 768, FFN = 2816, NGU = 2 * FFN;
constexpr int NPOS = 8200;
constexpr float EPSN = 1e-6f;
constexpr int Z_KR = 384, Z_CKV = 512, Z_U = 768, Z_V = 1280;
constexpr float QSCALE = 0.10206207261596575f * 1.4426950408889634f;
constexpr size_t O_Y = 0, O_CKVP = (size_t)MT * DM, O_KRP = O_CKVP + (size_t)MP * 256, O_CKVS = O_KRP + (size_t)MP * 32, O_KRS = O_CKVS + (size_t)MS * 256, O_VS = O_KRS + (size_t)MS * 32, O_END = O_VS + (size_t)MS * 512;

constexpr size_t MiB = 1u << 20;
constexpr size_t WS_CTL = 0, CTL_ZERO_BYTES = 1 * MiB;
constexpr size_t WS_ROPE = 1 * MiB;
constexpr size_t WS_WIN = 3 * MiB;
constexpr size_t WS_WQUP = 7 * MiB;
constexpr size_t WS_WKV = 8 * MiB;
constexpr size_t WS_WUKB = 9 * MiB;
constexpr size_t WS_WSB = 10 * MiB;
constexpr size_t WS_WOUT = 11 * MiB;
constexpr size_t WS_WGU = 13 * MiB;
constexpr size_t WS_WDN = 24 * MiB;
constexpr size_t WS_XN = 30 * MiB;
constexpr size_t WS_Z = 64 * MiB;
constexpr size_t WS_CQN = 124 * MiB;
constexpr size_t WS_CKVB = 137 * MiB;
constexpr size_t WS_KRB = 146 * MiB;
constexpr size_t WS_U = 148 * MiB;
constexpr size_t WS_VB = 165 * MiB;
constexpr size_t WS_Q = 182 * MiB;
constexpr size_t WS_KN = 208 * MiB;
constexpr size_t WS_VH = 224 * MiB;
constexpr size_t WS_QLAT = 240 * MiB;
constexpr size_t WS_ATT = 245 * MiB;
constexpr size_t WS_OPART = 509 * MiB;
constexpr size_t WS_ML = 541 * MiB;
constexpr size_t WS_MG = 279 * MiB;
constexpr size_t WS_X1 = 313 * MiB;
constexpr size_t WS_XN2 = 381 * MiB;
constexpr size_t WS_H = 415 * MiB;
constexpr size_t WS_SLAB = 542 * MiB;
constexpr size_t WS_END = 586 * MiB;
static_assert(WS_XN + (size_t)MT * 1024 * 2 <= WS_Z && WS_Z + (size_t)MT * NZ * 2 <= WS_CQN && WS_CQN + (size_t)MT * 384 * 2 <= WS_CKVB && WS_CKVB + (size_t)MT * 256 * 2 <= WS_KRB && WS_KRB + (size_t)MT * 32 * 2 <= WS_U, "ws map 1");
static_assert(WS_U + (size_t)MT * 512 * 2 <= WS_VB && WS_VB + (size_t)MT * 512 * 2 <= WS_Q && WS_Q + (size_t)MT * 768 * 2 <= WS_KN && WS_KN + (size_t)MP * 512 * 2 <= WS_VH && WS_VH + (size_t)MP * 512 * 2 <= WS_QLAT, "ws map 2");
static_assert(WS_QLAT + (size_t)MS * 8 * 288 * 2 <= WS_ATT && WS_ATT + (size_t)MT * 512 * 2 <= WS_MG && WS_H + (size_t)MT * FFN * 2 <= WS_OPART && WS_OPART + (size_t)128 * 4 * 64 * 256 * 4 <= WS_ML && WS_ML + 128 * 4 * 64 * 2 * 4 <= WS_SLAB && WS_SLAB + (size_t)11 * 1024 * 1024 * 4 <= WS_END, "ws map 3");
static_assert(WS_MG + (size_t)MT * 1024 * 2 <= WS_X1 && WS_X1 + (size_t)MT * 1024 * 4 <= WS_XN2 && WS_XN2 + (size_t)MT * 1024 * 2 <= WS_H, "ws map 4");
static_assert(WS_WIN + (size_t)NZ * 1024 * 2 <= WS_WQUP && WS_WGU + (size_t)NGU * 1024 * 2 <= WS_WDN && WS_WDN + (size_t)1024 * FFN * 2 <= WS_XN && WS_ROPE + (size_t)NPOS * 32 * 4 <= WS_WIN, "ws map 0");
constexpr int CW_TMO = 0, CW_CODE = 1;
constexpr int CW_BAR = 4096;
constexpr int CW_Q4 = 8192;

constexpr int RING_OFF = 0, RING_BYTES = 131072;
constexpr int LDS_BYTES = 147456;
constexpr int MISC_OFF = LDS_BYTES - 256;
constexpr int LDS_X = 131072;

struct Args { const float* in[24]; float* out; unsigned char* ws; int ph_lo, ph_hi; };
struct Ctx { LAS unsigned char* lds; int tid, lane, wave, vcu, G; };
typedef const __attribute__((address_space(4))) Args* kargs_t;
#define KARGS() ({ kargs_t p_ = (kargs_t)__builtin_amdgcn_kernarg_segment_ptr(); asm volatile("" : "+s"(p_)); p_; })

__device__ __forceinline__ float wave_sum(float v) {
#pragma unroll
    for (int o = 1; o < 64; o <<= 1) v += __shfl_xor(v, o);
    return v;
}
__device__ __forceinline__ float bf2f(unsigned short h) { return __builtin_bit_cast(float, (unsigned)h << 16); }
__device__ __forceinline__ float bflo(unsigned w) { return __builtin_bit_cast(float, w << 16); }
__device__ __forceinline__ float bfhi(unsigned w) { return __builtin_bit_cast(float, w & 0xffff0000u); }
#define LBAR() do { asm volatile("s_waitcnt lgkmcnt(0)" ::: "memory"); __builtin_amdgcn_s_barrier(); asm volatile("" ::: "memory"); } while (0)

__device__ __forceinline__ int drow_map(int mat, int c) {
    switch (mat) {
    case 0: if (c < 384) return c; if (c < 640) return Z_CKV + (c - 384); if (c < 672) return Z_KR + (c - 640); if (c < 1184) return Z_U + (c - 672); return Z_V + (c - 1184);
    case 1: { const int h = c / 96, i = c % 96; if (i < 64) return c; const int r = i - 64; return 96 * h + 64 + ((r < 16) ? 2 * r : 2 * (r - 16) + 1); }
    case 3: return 512 + c;
    case 5: return 256 * (c >> 7) + (c & 127);
    case 6: return 256 * (c >> 7) + 128 + (c & 127);
    default: return c;
    }
}
__device__ __forceinline__ void p0_transpose_item(const float* W, int K, int ldw, bf16* WT, const float* gk, int mat, LAS float* scr, int kb, int nb, int lane) {
    const int k0 = 64 * kb, n0 = 32 * nb;
#pragma unroll 8
    for (int i = 0; i < 32; ++i) { const int kk = 2 * i + (lane >> 5); float w = W[(size_t)(k0 + kk) * ldw + n0 + (lane & 31)]; if (gk) w *= gk[k0 + kk]; scr[kk * 33 + (lane & 31)] = w; }
    LDS_WAIT(); asm volatile("" ::: "memory");
    const int c = lane & 7;
#pragma unroll
    for (int j = 0; j < 4; ++j) { const int n = (lane >> 3) + 8 * j; const LAS float* s = scr + (8 * c) * 33 + n;
        v4u o; o.x = pk2(s[0 * 33], s[1 * 33]); o.y = pk2(s[2 * 33], s[3 * 33]); o.z = pk2(s[4 * 33], s[5 * 33]); o.w = pk2(s[6 * 33], s[7 * 33]);
        *(GAS v4u*)(WT + (size_t)drow_map(mat, n0 + n) * K + k0 + 8 * c) = o; }
    LDS_WAIT(); asm volatile("" ::: "memory");
}
__device__ __forceinline__ void rms_row_to_bf16(const float* xrow, bf16* orow, int lane) {
    const GAS f32x4* xr = (const GAS f32x4*)xrow + lane;
    f32x4 v[4]; float s = 0.f;
#pragma unroll
    for (int j = 0; j < 4; ++j) { v[j] = xr[64 * j]; s += (v[j].x * v[j].x + v[j].y * v[j].y) + (v[j].z * v[j].z + v[j].w * v[j].w); }
    const float rstd = 1.f / sqrtf(wave_sum(s) * (1.f / 1024.f) + EPSN);
    GAS unsigned long long* o8 = (GAS unsigned long long*)orow + lane;
#pragma unroll
    for (int j = 0; j < 4; ++j) o8[64 * j] = (unsigned long long)pk2(v[j].x * rstd, v[j].y * rstd) | ((unsigned long long)pk2(v[j].z * rstd, v[j].w * rstd) << 32);
}
__device__ __forceinline__ float rope_inv(int j) {
    switch (j) { case 0: return 1.0f; case 1: return 0.5623413324356079f; case 2: return 0.3162277638912201f; case 3: return 0.17782793939113617f; case 4: return 0.10000000149011612f;
    case 5: return 0.05623413249850273f; case 6: return 0.03162277489900589f; case 7: return 0.017782794311642647f; case 8: return 0.009999999776482582f; case 9: return 0.005623413249850273f;
    case 10: return 0.003162277629598975f; case 11: return 0.0017782794311642647f; case 12: return 0.0010000000474974513f; case 13: return 0.000562341301701963f; case 14: return 0.0003162277571391314f;
    default: return 0.00017782794020604342f; }
}
__device__ __forceinline__ void sincos_d(double a, double& cs, double& sn) {
    const double k = __builtin_rint(a * 0.63661977236758134308);
    double y = __builtin_fma(-k, 1.57079632679489655800e+00, a); y = __builtin_fma(-k, 6.12323399573676603587e-17, y);
    const double y2 = y * y;
    double sp = -1.0 / 1307674368000.0; sp = sp * y2 + 1.0 / 6227020800.0; sp = sp * y2 - 1.0 / 39916800.0; sp = sp * y2 + 1.0 / 362880.0; sp = sp * y2 - 1.0 / 5040.0; sp = sp * y2 + 1.0 / 120.0; sp = sp * y2 - 1.0 / 6.0; sp = sp * y2 + 1.0;
    const double s0 = y * sp;
    double cp = 1.0 / 20922789888000.0; cp = cp * y2 - 1.0 / 87178291200.0; cp = cp * y2 + 1.0 / 479001600.0; cp = cp * y2 - 1.0 / 3628800.0; cp = cp * y2 + 1.0 / 40320.0; cp = cp * y2 - 1.0 / 720.0; cp = cp * y2 + 1.0 / 24.0; cp = cp * y2 - 0.5; cp = cp * y2 + 1.0;
    const int q = ((int)k) & 3;
    cs = (q == 0) ? cp : (q == 1) ? -s0 : (q == 2) ? -cp : s0;
    sn = (q == 0) ? s0 : (q == 1) ? cp : (q == 2) ? -s0 : -cp;
}
__device__ __forceinline__ void p0_prologue(kargs_t A, const Ctx& C) {
    unsigned char* ws = A->ws;
    LAS float* scr = (LAS float*)(C.lds + RING_OFF + C.wave * 16384);
    const int gw = C.vcu * NWAVES + C.wave, NGW = C.G * NWAVES;
    constexpr int NITEMS = 5856;
    for (int it = gw; it < NITEMS; it += NGW) {
        int mat, r;
        if (it < 848) { mat = 0; r = it; } else if (it < 992) { mat = 1; r = it - 848; } else if (it < 1056) { mat = 2; r = it - 992; } else if (it < 1120) { mat = 3; r = it - 1056; }
        else if (it < 1632) { mat = 4; r = it - 1120; } else if (it < 3040) { mat = 5; r = it - 1632; } else if (it < 4448) { mat = 6; r = it - 3040; } else { mat = 7; r = it - 4448; }
        const float* W; int K, ldw; bf16* WT; const float* gk = nullptr;
        switch (mat) {
        case 0: W = A->in[6]; K = 1024; ldw = 1696; WT = (bf16*)(ws + WS_WIN); gk = A->in[5]; break;
        case 1: W = A->in[8]; K = 384; ldw = 768; WT = (bf16*)(ws + WS_WQUP); gk = A->in[7]; break;
        case 2: W = A->in[10]; K = 256; ldw = 512; WT = (bf16*)(ws + WS_WKV); break;
        case 3: W = A->in[11]; K = 256; ldw = 512; WT = (bf16*)(ws + WS_WKV); break;
        case 4: W = A->in[18]; K = 1024; ldw = 1024; WT = (bf16*)(ws + WS_WOUT); break;
        case 5: W = A->in[20]; K = 1024; ldw = 2816; WT = (bf16*)(ws + WS_WGU); gk = A->in[19]; break;
        case 6: W = A->in[21]; K = 1024; ldw = 2816; WT = (bf16*)(ws + WS_WGU); gk = A->in[19]; break;
        default: W = A->in[22]; K = 2816; ldw = 1024; WT = (bf16*)(ws + WS_WDN); break;
        }
        const int nblk = ldw / 32, kb = r / nblk, nb = r % nblk;
        if (mat == 4) gk = (kb < 8) ? A->in[16] : (A->in[17] - 512);
        p0_transpose_item(W, K, ldw, WT, gk, mat, scr, kb, nb, C.lane);
    }
    const int gt = C.vcu * (NWAVES * 64) + C.tid, NGT = C.G * NWAVES * 64;
    {
        const float* w = A->in[10]; bf16* d = (bf16*)(ws + WS_WUKB);
        for (int i = gt; i < 16384; i += NGT) { const f32x4 a = *(const f32x4*)(w + 8 * (size_t)i), b = *(const f32x4*)(w + 8 * (size_t)i + 4);
            v4u o; o.x = pk2(a.x, a.y); o.y = pk2(a.z, a.w); o.z = pk2(b.x, b.y); o.w = pk2(b.z, b.w); *(v4u*)(d + 8 * (size_t)i) = o; }
    }
    {
        const float* w = A->in[14]; bf16* d = (bf16*)(ws + WS_WSB);
        for (int i = gt; i < 16384; i += NGT) { const int e = 8 * i, ii = (e >> 7) & 127, j0 = e & 127;
            const f32x4 a = *(const f32x4*)(w + e), b = *(const f32x4*)(w + e + 4); float t[8] = {a.x, a.y, a.z, a.w, b.x, b.y, b.z, b.w};
#pragma unroll
            for (int k = 0; k < 8; ++k) if (j0 + k > ii) t[k] = 0.f;
            v4u o; o.x = pk2(t[0], t[1]); o.y = pk2(t[2], t[3]); o.z = pk2(t[4], t[5]); o.w = pk2(t[6], t[7]); *(v4u*)(d + e) = o; }
    }
    {
        bf16* d = (bf16*)(ws + WS_WIN) + (size_t)416 * 1024;
        for (int i = gt; i < 12288; i += NGT) *(v4u*)(d + 8 * (size_t)i) = (v4u){0u, 0u, 0u, 0u};
    }
    {
        float* d = (float*)(ws + WS_ROPE);
        for (int i = gt; i < NPOS * 16; i += NGT) { const int pos = i >> 4, j = i & 15;
            const float ang = (float)pos * rope_inv(j); double cs, sn; sincos_d((double)ang, cs, sn);
            d[2 * i] = (float)cs; d[2 * i + 1] = (float)sn; }
    }
    for (int m = gw; m < MT; m += NGW) {
        const float* xr = (m < MP) ? (A->in[0] + (size_t)m * DM) : (A->in[1] + (size_t)(m - MP) * DM);
        rms_row_to_bf16(xr, (bf16*)(ws + WS_XN) + (size_t)m * DM, C.lane);
    }
}

__device__ __forceinline__ float gelu_erf(float v) { return 0.5f * v * (1.0f + erff(v * 0.70710678118654752f)); }
__device__ __forceinline__ void p2_post(kargs_t A, const Ctx& C) {
    unsigned char* ws = A->ws; const int lane = C.lane;
    const int gw = C.vcu * NWAVES + C.wave, NGW = C.G * NWAVES;
    const bf16* Z = (const bf16*)(ws + WS_Z);
    const float* rope = (const float*)(ws + WS_ROPE);
    const f32x4 gkv = *(const f32x4*)(A->in[9] + 4 * lane);
    const f32x4 gv0 = *(const f32x4*)(A->in[12] + 8 * lane), gv1 = *(const f32x4*)(A->in[12] + 8 * lane + 4);
    const f32x4 bv0 = *(const f32x4*)(A->in[13] + 8 * lane), bv1 = *(const f32x4*)(A->in[13] + 8 * lane + 4);
    for (int m = gw; m < MT; m += NGW) {
        const bf16* zr = Z + (size_t)m * NZ;
        v4u wq = (v4u){0u, 0u, 0u, 0u}; if (lane < 48) wq = *(const v4u*)(zr + 8 * lane);
        const unsigned long long wk = *(const unsigned long long*)(zr + Z_CKV + 4 * lane);
        const v4u wu = *(const v4u*)(zr + Z_U + 8 * lane), wv = *(const v4u*)(zr + Z_V + 8 * lane);
        float x1 = 0.f, x2 = 0.f; if (lane < 16) { x1 = bf2f(zr[Z_KR + lane]); x2 = bf2f(zr[Z_KR + 16 + lane]); }
        float cq[8] = {bflo(wq.x), bfhi(wq.x), bflo(wq.y), bfhi(wq.y), bflo(wq.z), bfhi(wq.z), bflo(wq.w), bfhi(wq.w)};
        float ck[4] = {bflo((unsigned)wk), bfhi((unsigned)wk), bflo((unsigned)(wk >> 32)), bfhi((unsigned)(wk >> 32))};
        float uu[8] = {bflo(wu.x), bfhi(wu.x), bflo(wu.y), bfhi(wu.y), bflo(wu.z), bfhi(wu.z), bflo(wu.w), bfhi(wu.w)};
        float vv[8] = {bflo(wv.x), bfhi(wv.x), bflo(wv.y), bfhi(wv.y), bflo(wv.z), bfhi(wv.z), bflo(wv.w), bfhi(wv.w)};
        float sq = 0.f, sk = 0.f, sv = 0.f;
#pragma unroll
        for (int k = 0; k < 8; ++k) { sq += cq[k] * cq[k]; uu[k] = gelu_erf(uu[k]); vv[k] = gelu_erf(vv[k]); sv += vv[k]; }
#pragma unroll
        for (int k = 0; k < 4; ++k) sk += ck[k] * ck[k];
#pragma unroll
        for (int o = 1; o < 64; o <<= 1) { sq += __shfl_xor(sq, o); sk += __shfl_xor(sk, o); sv += __shfl_xor(sv, o); }
        const float mean = sv * (1.f / 512.f); float s2 = 0.f;
#pragma unroll
        for (int k = 0; k < 8; ++k) { vv[k] -= mean; s2 += vv[k] * vv[k]; }
        s2 = wave_sum(s2);
        const float rq = 1.f / sqrtf(sq * (1.f / 384.f) + EPSN), rk = 1.f / sqrtf(sk * (1.f / 256.f) + EPSN), rv = 1.f / sqrtf(s2 * (1.f / 512.f) + EPSN);
        if (lane < 48) { v4u o; o.x = pk2(cq[0] * rq, cq[1] * rq); o.y = pk2(cq[2] * rq, cq[3] * rq); o.z = pk2(cq[4] * rq, cq[5] * rq); o.w = pk2(cq[6] * rq, cq[7] * rq);
            *(v4u*)((bf16*)(ws + WS_CQN) + (size_t)m * QRK + 8 * lane) = o; }
        { f32x4 o; o.x = ck[0] * rk * gkv.x; o.y = ck[1] * rk * gkv.y; o.z = ck[2] * rk * gkv.z; o.w = ck[3] * rk * gkv.w;
          float* dst = (m < MP) ? (A->out + O_CKVP + (size_t)m * 256) : (A->out + O_CKVS + (size_t)(m - MP) * 256);
          *(f32x4*)(dst + 4 * lane) = o;
          *(unsigned long long*)((bf16*)(ws + WS_CKVB) + (size_t)m * 256 + 4 * lane) = (unsigned long long)pk2(o.x, o.y) | ((unsigned long long)pk2(o.z, o.w) << 32); }
        if (lane < 16) { const int pos = (m < MP) ? (m & 8191) : 8192 + ((m - MP) & 7);
            const float c = rope[((size_t)pos * 16 + lane) * 2], s = rope[((size_t)pos * 16 + lane) * 2 + 1];
            const float o1 = x1 * c - x2 * s, o2 = x1 * s + x2 * c;
            float* dst = (m < MP) ? (A->out + O_KRP + (size_t)m * 32) : (A->out + O_KRS + (size_t)(m - MP) * 32);
            dst[lane] = o1; dst[16 + lane] = o2;
            *(unsigned*)((bf16*)(ws + WS_KRB) + (size_t)m * 32 + 2 * lane) = pk2(o1, o2); }
        { v4u o; o.x = pk2(uu[0], uu[1]); o.y = pk2(uu[2], uu[3]); o.z = pk2(uu[4], uu[5]); o.w = pk2(uu[6], uu[7]); *(v4u*)((bf16*)(ws + WS_U) + (size_t)m * 512 + 8 * lane) = o; }
        { float y[8];
          y[0] = vv[0] * rv * gv0.x + bv0.x; y[1] = vv[1] * rv * gv0.y + bv0.y; y[2] = vv[2] * rv * gv0.z + bv0.z; y[3] = vv[3] * rv * gv0.w + bv0.w;
          y[4] = vv[4] * rv * gv1.x + bv1.x; y[5] = vv[5] * rv * gv1.y + bv1.y; y[6] = vv[6] * rv * gv1.z + bv1.z; y[7] = vv[7] * rv * gv1.w + bv1.w;
          v4u o; o.x = pk2(y[0], y[1]); o.y = pk2(y[2], y[3]); o.z = pk2(y[4], y[5]); o.w = pk2(y[6], y[7]); *(v4u*)((bf16*)(ws + WS_VB) + (size_t)m * 512 + 8 * lane) = o;
          if (m >= MP) { float* dst = A->out + O_VS + (size_t)(m - MP) * 512 + 8 * lane; *(f32x4*)dst = (f32x4){y[0], y[1], y[2], y[3]}; *(f32x4*)(dst + 4) = (f32x4){y[4], y[5], y[6], y[7]}; } }
    }
}

__device__ __forceinline__ void p7_xn2(kargs_t A, const Ctx& C) {
    const int gw = C.vcu * NWAVES + C.wave, NGW = C.G * NWAVES, lane = C.lane;
    for (int m = gw; m < MT; m += NGW) {
        GAS f32x4* x1r = (GAS f32x4*)((float*)(A->ws + WS_X1) + (size_t)m * DM) + lane;
        f32x4 v[4];
        if (m >= MP) {
            const GAS f32x4* xs = (const GAS f32x4*)(A->in[1] + (size_t)(m - MP) * DM) + lane; const GAS f32x4* sl = (const GAS f32x4*)((const float*)(A->ws + WS_SLAB) + (size_t)(m - MP) * DM) + lane;
#pragma unroll
            for (int j = 0; j < 4; ++j) { v[j] = xs[64 * j];
#pragma unroll
                for (int k = 0; k < 4; ++k) v[j] += sl[(size_t)k * (MS * DM / 4) + 64 * j];
                x1r[64 * j] = v[j]; }
        } else {
#pragma unroll
            for (int j = 0; j < 4; ++j) v[j] = x1r[64 * j];
        }
        float s = 0.f;
#pragma unroll
        for (int j = 0; j < 4; ++j) s += (v[j].x * v[j].x + v[j].y * v[j].y) + (v[j].z * v[j].z + v[j].w * v[j].w);
        const float rstd = 1.f / sqrtf(wave_sum(s) * (1.f / 1024.f) + EPSN);
        GAS unsigned long long* o8 = (GAS unsigned long long*)((bf16*)(A->ws + WS_XN2) + (size_t)m * DM) + lane;
#pragma unroll
        for (int j = 0; j < 4; ++j) o8[64 * j] = (unsigned long long)pk2(v[j].x * rstd, v[j].y * rstd) | ((unsigned long long)pk2(v[j].z * rstd, v[j].w * rstd) << 32);
    }
}
__device__ __forceinline__ void p10_final(kargs_t A, const Ctx& C) {
    const int gw = C.vcu * NWAVES + C.wave, NGW = C.G * NWAVES, lane = C.lane;
    f32x4 g[4];
#pragma unroll
    for (int j = 0; j < 4; ++j) g[j] = *((const f32x4*)A->in[23] + lane + 64 * j);
    for (int m = gw; m < MT; m += NGW) {
        GAS f32x4* xr = (GAS f32x4*)(A->out + O_Y + (size_t)m * DM) + lane;
        f32x4 v[4]; float s = 0.f;
        if (m >= MP) {
            const GAS f32x4* x1 = (const GAS f32x4*)((const float*)(A->ws + WS_X1) + (size_t)m * DM) + lane; const GAS f32x4* sl = (const GAS f32x4*)((const float*)(A->ws + WS_SLAB) + (size_t)(m - MP) * DM) + lane;
#pragma unroll
            for (int j = 0; j < 4; ++j) { v[j] = x1[64 * j];
#pragma unroll
                for (int k = 0; k < 11; ++k) v[j] += sl[(size_t)k * (MS * DM / 4) + 64 * j]; }
        } else {
#pragma unroll
            for (int j = 0; j < 4; ++j) v[j] = xr[64 * j];
        }
#pragma unroll
        for (int j = 0; j < 4; ++j) s += (v[j].x * v[j].x + v[j].y * v[j].y) + (v[j].z * v[j].z + v[j].w * v[j].w);
        const float rstd = 1.f / sqrtf(wave_sum(s) * (1.f / 1024.f) + EPSN);
#pragma unroll
        for (int j = 0; j < 4; ++j) xr[64 * j] = v[j] * rstd * g[j];
    }
}

typedef float f32x16 __attribute__((ext_vector_type(16)));
typedef short s16x4 __attribute__((ext_vector_type(4)));
typedef LAS const unsigned char* ldsc_t;
__device__ __forceinline__ int crow16(int r, int hi) { return (r & 3) + 8 * (r >> 2) + 4 * hi; }
__device__ __forceinline__ s16x4 tr_read(ldsc_t p) { typedef short v4i16_t __attribute__((ext_vector_type(4))); return __builtin_bit_cast(s16x4, __builtin_amdgcn_ds_read_tr16_b64_v4i16((LAS v4i16_t*)p)); }
#define MFMA32(a, b, c) __builtin_amdgcn_mfma_f32_32x32x16_bf16(a, b, c, 0, 0, 0)

constexpr int DEC_QI = 0, DEC_KI = 37888, DEC_PI = DEC_KI + 75776, DEC_MX = DEC_PI + 17408, DEC_SM = DEC_MX + 1024, DEC_AL = DEC_SM + 1024, DEC_END = DEC_AL + 256;
constexpr int DSPLIT = 4, DPG = 64 / DSPLIT;
constexpr int DEC_KP = 592, DEC_PP = 272;
static_assert(DEC_END <= MISC_OFF, "decode LDS map");
__device__ __forceinline__ void decode_item(kargs_t A, const Ctx& C, int s, int sp) {
    const int tid = C.tid, lane = C.lane, wid = C.wave, r32 = lane & 31, hi = lane >> 5;
    LAS unsigned char* lds = C.lds;
    const float* cck = A->in[2]; const float* ckr = A->in[3]; const int* ptab = (const int*)A->in[4] + s * 64 + DPG * sp;
    { const bf16* Qs = (const bf16*)(A->ws + WS_Q) + (size_t)(MP + 8 * s) * NQ; const bf16* WU = (const bf16*)(A->ws + WS_WUKB);
      for (int it = wid; it < 64; it += 8) { const int ct = it & 7, h = it >> 3;
          f32x16 acc = {};
#pragma unroll
          for (int ks = 0; ks < 4; ++ks) {
              const bf16x8 a = *(const bf16x8*)(Qs + (size_t)(r32 & 7) * NQ + 96 * h + 16 * ks + 8 * hi);
              const bf16x8 b = *(const bf16x8*)(WU + (size_t)(32 * ct + r32) * 512 + 64 * h + 16 * ks + 8 * hi);
              acc = MFMA32(a, b, acc); }
#pragma unroll
          for (int r = 0; r < 4; ++r) *(LAS bf16*)(lds + DEC_QI + ((r + 4 * hi) * 8 + h) * DEC_KP + (32 * ct + r32) * 2) = (bf16)f2bf(acc[r]); }
      for (int e = tid; e < 2048; e += 512) { const int qq = e >> 5, i = e & 31, t = qq >> 3, h = qq & 7;
          *(LAS bf16*)(lds + DEC_QI + qq * DEC_KP + (256 + i) * 2) = Qs[(size_t)t * NQ + 96 * h + 64 + ((i < 16) ? 2 * i : 2 * (i - 16) + 1)]; } }
    const int kb = wid & 3, qb = wid >> 2;
    const int q = 32 * qb + r32;
    float m_run = -INFINITY, l_run = 0.f; f32x16 o0 = {}, o1 = {};
    const int NT = DPG + (sp == DSPLIT - 1 ? 1 : 0);
    f32x4 pre[18];
#define DEC_LOAD(tile) do { if ((tile) < DPG) { const int pg = ptab[(tile)]; const float* pc = cck + (size_t)pg * 32768; const float* pr = ckr + (size_t)pg * 4096; \
        _Pragma("unroll") for (int i = 0; i < 16; ++i) pre[i] = __builtin_nontemporal_load((const f32x4*)(pc + 4 * (size_t)(tid + 512 * i))); \
        _Pragma("unroll") for (int i = 0; i < 2; ++i) pre[16 + i] = __builtin_nontemporal_load((const f32x4*)(pr + 4 * (size_t)(tid + 512 * i))); } \
      else { _Pragma("unroll") for (int i = 0; i < 18; ++i) pre[i] = (f32x4){0.f, 0.f, 0.f, 0.f}; \
        pre[0] = *(const f32x4*)(A->out + O_CKVS + (size_t)s * 2048 + 4 * tid); if (tid < 64) pre[16] = *(const f32x4*)(A->out + O_KRS + (size_t)s * 256 + 4 * tid); } } while (0)
    DEC_LOAD(0);
    for (int t = 0; t < NT; ++t) {
#pragma unroll
        for (int i = 0; i < 16; ++i) { const int f = tid + 512 * i; *(LAS unsigned long long*)(lds + DEC_KI + (f >> 6) * DEC_KP + (f & 63) * 8) = (unsigned long long)pk2(pre[i].x, pre[i].y) | ((unsigned long long)pk2(pre[i].z, pre[i].w) << 32); }
#pragma unroll
        for (int i = 0; i < 2; ++i) { const int f = tid + 512 * i; *(LAS unsigned long long*)(lds + DEC_KI + (f >> 3) * DEC_KP + 512 + (f & 7) * 8) = (unsigned long long)pk2(pre[16 + i].x, pre[16 + i].y) | ((unsigned long long)pk2(pre[16 + i].z, pre[16 + i].w) << 32); }
        if (t + 1 < NT) DEC_LOAD(t + 1);
        LBAR();
        f32x16 sc = {};
        { ldsc_t ka = lds + DEC_KI + (32 * kb + r32) * DEC_KP + hi * 16, qa = lds + DEC_QI + q * DEC_KP + hi * 16;
#pragma unroll
          for (int ks = 0; ks < 18; ++ks) { const bf16x8 a = *(LAS const bf16x8*)(ka + ks * 32), b = *(LAS const bf16x8*)(qa + ks * 32); sc = MFMA32(a, b, sc); } }
        if (t == DPG) { const int tq = q >> 3;
#pragma unroll
            for (int r = 0; r < 16; ++r) if (32 * kb + crow16(r, hi) > tq) sc[r] = -INFINITY; }
        float mx = sc[0];
#pragma unroll
        for (int r = 1; r < 16; ++r) mx = fmaxf(mx, sc[r]);
        mx = fmaxf(mx, __shfl_xor(mx, 32));
        if (hi == 0) *(LAS float*)(lds + DEC_MX + (kb * 64 + q) * 4) = mx;
        LBAR();
        float tm = *(LAS const float*)(lds + DEC_MX + q * 4);
#pragma unroll
        for (int k = 1; k < 4; ++k) tm = fmaxf(tm, *(LAS const float*)(lds + DEC_MX + (k * 64 + q) * 4));
        const float m_new = fmaxf(m_run, tm), alpha = __builtin_amdgcn_exp2f(m_run - m_new);
        float ps = 0.f;
#pragma unroll
        for (int r = 0; r < 16; ++r) { sc[r] = __builtin_amdgcn_exp2f(sc[r] - m_new); ps += sc[r]; }
        ps += __shfl_xor(ps, 32);
#pragma unroll
        for (int i = 0; i < 4; ++i) *(LAS unsigned long long*)(lds + DEC_PI + q * DEC_PP + (32 * kb + 8 * i + 4 * hi) * 2) = (unsigned long long)pk2(sc[4 * i], sc[4 * i + 1]) | ((unsigned long long)pk2(sc[4 * i + 2], sc[4 * i + 3]) << 32);
        if (hi == 0) { *(LAS float*)(lds + DEC_SM + (kb * 64 + q) * 4) = ps; if (kb == 0) *(LAS float*)(lds + DEC_AL + q * 4) = alpha; }
        m_run = m_new;
        LBAR();
        { float ss = 0.f;
#pragma unroll
          for (int k = 0; k < 4; ++k) ss += *(LAS const float*)(lds + DEC_SM + (k * 64 + q) * 4);
          l_run = l_run * alpha + ss; }
#pragma unroll
        for (int r = 0; r < 16; ++r) { const float al = *(LAS const float*)(lds + DEC_AL + (32 * qb + crow16(r, hi)) * 4); o0[r] *= al; o1[r] *= al; }
        { ldsc_t pa = lds + DEC_PI + q * DEC_PP + hi * 16;
          ldsc_t va = lds + DEC_KI + (8 * hi + ((lane & 15) >> 2)) * DEC_KP + (64 * kb + 16 * ((lane >> 4) & 1) + 4 * (lane & 3)) * 2;
#pragma unroll
          for (int ks = 0; ks < 8; ++ks) {
              const bf16x8 a = *(LAS const bf16x8*)(pa + ks * 32);
              const s16x4 v00 = tr_read(va + ks * 16 * DEC_KP), v01 = tr_read(va + (ks * 16 + 4) * DEC_KP), v10 = tr_read(va + ks * 16 * DEC_KP + 64), v11 = tr_read(va + (ks * 16 + 4) * DEC_KP + 64);
              o0 = MFMA32(a, ((bf16x8){v00[0], v00[1], v00[2], v00[3], v01[0], v01[1], v01[2], v01[3]}), o0);
              o1 = MFMA32(a, ((bf16x8){v10[0], v10[1], v10[2], v10[3], v11[0], v11[1], v11[2], v11[3]}), o1);
          } }
        LBAR();
    }
#undef DEC_LOAD
    int qo = q, r32o = r32; asm volatile("" : "+v"(qo), "+v"(r32o));
    if (kb == 0 && hi == 0) { float* ml = (float*)(A->ws + WS_ML) + ((size_t)(s * DSPLIT + sp) * 64 + qo) * 2; ml[0] = m_run; ml[1] = l_run; }
    { float* op = (float*)(A->ws + WS_OPART) + (size_t)(s * DSPLIT + sp) * 64 * 256;
#pragma unroll
      for (int r = 0; r < 16; ++r) { const int row = 32 * qb + crow16(r, hi); op[(size_t)row * 256 + 64 * kb + r32o] = o0[r]; op[(size_t)row * 256 + 64 * kb + 32 + r32o] = o1[r]; } }
}
__device__ __forceinline__ void gate_prompt_item(kargs_t A, const Ctx& C, int ci) {
    const int lane = C.lane, g = C.wave, r32 = lane & 31, hi = lane >> 5; const int R0 = 128 * ci;
    LAS unsigned char* img = C.lds + g * 16384;
    const bf16* Vb = (const bf16*)(A->ws + WS_VB); const bf16* U = (const bf16*)(A->ws + WS_U); const bf16* WS = (const bf16*)(A->ws + WS_WSB) + (size_t)g * 16384;
    bf16* MG = (bf16*)(A->ws + WS_MG);
#pragma unroll
    for (int i = 0; i < 16; ++i) { const int e = lane + 64 * i, row = e >> 3, ch = e & 7;
        *(LAS v4u*)(img + (ch >> 2) * 8192 + row * 64 + (ch & 3) * 16) = *(const v4u*)(Vb + (size_t)(R0 + row) * 512 + 64 * g + ch * 8); }
    LDS_WAIT(); asm volatile("" ::: "memory");
    ldsc_t va = img + (8 * hi + ((lane & 15) >> 2)) * 64 + (16 * ((lane >> 4) & 1) + 4 * (lane & 3)) * 2;
    LAS float* ssq = (LAS float*)(C.lds + LDS_X);
#pragma unroll
    for (int hf = 0; hf < 2; ++hf) {
        f32x16 acc[2][2];
#pragma unroll
        for (int mm = 0; mm < 2; ++mm) { acc[mm][0] = (f32x16){}; acc[mm][1] = (f32x16){}; }
#pragma unroll
        for (int mm = 0; mm < 2; ++mm) { const int mt = 2 * hf + mm;
#pragma unroll
            for (int ks = 0; ks < 2 * mt + 2; ++ks) {
                const bf16x8 b = *(const bf16x8*)(WS + (size_t)(32 * mt + r32) * 128 + 16 * ks + 8 * hi);
#pragma unroll
                for (int nt = 0; nt < 2; ++nt) { const s16x4 v0 = tr_read(va + nt * 8192 + ks * 16 * 64), v1 = tr_read(va + nt * 8192 + (ks * 16 + 4) * 64);
                    acc[mm][nt] = MFMA32(((bf16x8){v0[0], v0[1], v0[2], v0[3], v1[0], v1[1], v1[2], v1[3]}), b, acc[mm][nt]); }
            } }
#pragma unroll
        for (int mm = 0; mm < 2; ++mm) { const int i = 32 * (2 * hf + mm) + r32; const float bs = A->in[15][g * 128 + i]; float sq = 0.f;
#pragma unroll
            for (int nt = 0; nt < 2; ++nt)
#pragma unroll
                for (int qd = 0; qd < 4; ++qd) { const unsigned long long uw = *(const unsigned long long*)(U + (size_t)(R0 + i) * 512 + 64 * g + 32 * nt + 8 * qd + 4 * hi);
                    const float u0 = bflo((unsigned)uw), u1 = bfhi((unsigned)uw), u2 = bflo((unsigned)(uw >> 32)), u3 = bfhi((unsigned)(uw >> 32));
                    const float g0 = u0 * (acc[mm][nt][4 * qd] + bs), g1 = u1 * (acc[mm][nt][4 * qd + 1] + bs), g2 = u2 * (acc[mm][nt][4 * qd + 2] + bs), g3 = u3 * (acc[mm][nt][4 * qd + 3] + bs);
                    acc[mm][nt][4 * qd] = g0; acc[mm][nt][4 * qd + 1] = g1; acc[mm][nt][4 * qd + 2] = g2; acc[mm][nt][4 * qd + 3] = g3;
                    sq += (g0 * g0 + g1 * g1) + (g2 * g2 + g3 * g3); }
            sq += __shfl_xor(sq, 32);
            if (hi == 0) ssq[g * 128 + i] = sq; }
        LBAR();
#pragma unroll
        for (int mm = 0; mm < 2; ++mm) { const int i = 32 * (2 * hf + mm) + r32; float t = 0.f;
#pragma unroll
            for (int k = 0; k < 8; ++k) t += ssq[k * 128 + i];
            const float rs = 1.f / sqrtf(t * (1.f / 512.f) + EPSN);
#pragma unroll
            for (int nt = 0; nt < 2; ++nt)
#pragma unroll
                for (int qd = 0; qd < 4; ++qd)
                    *(unsigned long long*)(MG + (size_t)(R0 + i) * 1024 + 512 + 64 * g + 32 * nt + 8 * qd + 4 * hi) =
                        (unsigned long long)pk2(acc[mm][nt][4 * qd] * rs, acc[mm][nt][4 * qd + 1] * rs) | ((unsigned long long)pk2(acc[mm][nt][4 * qd + 2] * rs, acc[mm][nt][4 * qd + 3] * rs) << 32); }
    }
    const bf16* AT = (const bf16*)(A->ws + WS_ATT);
    for (int rr = 0; rr < 16; ++rr) { const size_t row = (size_t)R0 + 16 * g + rr; const v4u w = *(const v4u*)(AT + row * 512 + 8 * lane);
        float x[8] = {bflo(w.x), bfhi(w.x), bflo(w.y), bfhi(w.y), bflo(w.z), bfhi(w.z), bflo(w.w), bfhi(w.w)}; float sq = 0.f;
#pragma unroll
        for (int k = 0; k < 8; ++k) sq += x[k] * x[k];
        const float rs = 1.f / sqrtf(wave_sum(sq) * (1.f / 512.f) + EPSN);
        v4u o; o.x = pk2(x[0] * rs, x[1] * rs); o.y = pk2(x[2] * rs, x[3] * rs); o.z = pk2(x[4] * rs, x[5] * rs); o.w = pk2(x[6] * rs, x[7] * rs);
        *(v4u*)(MG + row * 1024 + 8 * lane) = o; }
    LBAR();
}
__device__ __forceinline__ void gate_sample_item(kargs_t A, const Ctx& C, int s) {
    const int tid = C.tid, lane = C.lane, h = C.wave;
    LAS float* ol = (LAS float*)C.lds;
    LAS float* red = (LAS float*)(C.lds + 65536);
    bf16* MG = (bf16*)(A->ws + WS_MG);
    { const float* ml = (const float*)(A->ws + WS_ML) + (size_t)s * DSPLIT * 64 * 2; const float* op = (const float*)(A->ws + WS_OPART) + (size_t)s * DSPLIT * 64 * 256;
      for (int e = tid; e < 4096; e += 512) { const int row = e >> 6, c4 = e & 63;
          float mm = -INFINITY;
#pragma unroll
          for (int j = 0; j < DSPLIT; ++j) mm = fmaxf(mm, ml[(j * 64 + row) * 2]);
          float den = 0.f; f32x4 acc = (f32x4){0.f, 0.f, 0.f, 0.f};
#pragma unroll
          for (int j = 0; j < DSPLIT; ++j) { const float w = __builtin_amdgcn_exp2f(ml[(j * 64 + row) * 2] - mm); den += w * ml[(j * 64 + row) * 2 + 1];
              acc += *(const f32x4*)(op + (size_t)(j * 64 + row) * 256 + 4 * c4) * w; }
          *(LAS f32x4*)(ol + row * 256 + 4 * c4) = acc * (1.f / den); } }
    LBAR();
    float av[8];
#pragma unroll
    for (int t = 0; t < 8; ++t) av[t] = 0.f;
    { const bf16* wr = (const bf16*)(A->ws + WS_WKV) + (size_t)(512 + 64 * h + lane) * 256;
      for (int r0 = 0; r0 < 256; r0 += 8) { const v4u w = *(const v4u*)(wr + r0);
          const float wf[8] = {bflo(w.x), bfhi(w.x), bflo(w.y), bfhi(w.y), bflo(w.z), bfhi(w.z), bflo(w.w), bfhi(w.w)};
#pragma unroll
          for (int t = 0; t < 8; ++t) { const f32x4 x0 = *(LAS const f32x4*)(ol + (t * 8 + h) * 256 + r0), x1 = *(LAS const f32x4*)(ol + (t * 8 + h) * 256 + r0 + 4);
              av[t] += (x0.x * wf[0] + x0.y * wf[1]) + (x0.z * wf[2] + x0.w * wf[3]) + (x1.x * wf[4] + x1.y * wf[5]) + (x1.z * wf[6] + x1.w * wf[7]); } } }
#pragma unroll
    for (int t = 0; t < 8; ++t) { const float sq = wave_sum(av[t] * av[t]); if (lane == 0) red[h * 8 + t] = sq; }
    LBAR();
#pragma unroll
    for (int t = 0; t < 8; ++t) { float tt = 0.f;
#pragma unroll
        for (int k = 0; k < 8; ++k) tt += red[k * 8 + t];
        const float rs = 1.f / sqrtf(tt * (1.f / 512.f) + EPSN);
        MG[(size_t)(MP + 8 * s + t) * 1024 + 64 * h + lane] = (bf16)f2bf(av[t] * rs); }
    LBAR();
    { const int c = tid, g = h; const bf16* Vb = (const bf16*)(A->ws + WS_VB) + (size_t)(MP + 8 * s) * 512 + c; const bf16* U = (const bf16*)(A->ws + WS_U) + (size_t)(MP + 8 * s) * 512 + c;
      float vv[8], gg[8];
#pragma unroll
      for (int j = 0; j < 8; ++j) vv[j] = bf2f(Vb[j * 512]);
#pragma unroll
      for (int t = 0; t < 8; ++t) { float mix = A->in[15][g * 128 + t];
#pragma unroll
          for (int j = 0; j < 8; ++j) if (j <= t) mix += A->in[14][(size_t)g * 16384 + t * 128 + j] * vv[j];
          gg[t] = bf2f(U[t * 512]) * mix; const float sq = wave_sum(gg[t] * gg[t]); if (lane == 0) red[g * 8 + t] = sq; }
      LBAR();
#pragma unroll
      for (int t = 0; t < 8; ++t) { float tt = 0.f;
#pragma unroll
          for (int k = 0; k < 8; ++k) tt += red[k * 8 + t];
          const float rs = 1.f / sqrtf(tt * (1.f / 512.f) + EPSN);
          MG[(size_t)(MP + 8 * s + t) * 1024 + 512 + c] = (bf16)f2bf(gg[t] * rs); } }
    LBAR();
}
__device__ __forceinline__ void p5_gate(kargs_t A, const Ctx& C) {
    for (int it = C.vcu; it < 256; it += C.G) { if (it < 128) gate_prompt_item(A, C, it); else gate_sample_item(A, C, it - 128); }
}


__device__ __forceinline__ void p4_queue(kargs_t A, const Ctx& C0, gu32* ctl, int bx, int wave_s, char* shm  ) {
    volatile LAS unsigned* slot = (volatile LAS unsigned*)(C0.lds + MISC_OFF) + 8;
    const int x = bx & 7;
    const attn_body::bf16* Qp = (const attn_body::bf16*)(A->ws + WS_Q); const attn_body::bf16* Kp = (const attn_body::bf16*)(A->ws + WS_KN); const attn_body::bf16* KRp = (const attn_body::bf16*)(A->ws + WS_KRB);
    const attn_body::bf16* Vp = (const attn_body::bf16*)(A->ws + WS_VH); attn_body::bf16* Op = (attn_body::bf16*)(A->ws + WS_ATT);
    for (;;) {
        if (wave_s == 0 && lane_now() == 0) slot[0] = __hip_atomic_fetch_add(ctl + CW_Q4 + 64 * x, 1u, __ATOMIC_RELAXED, __HIP_MEMORY_SCOPE_AGENT);
        LBAR();
        const unsigned e = (unsigned)__builtin_amdgcn_readfirstlane((int)slot[0]);
        LBAR();
        if (e >= 128u) break;
        if (e < 64u) { const int i = (int)e, bh = 2 * x + (i & 1), qb = 31 - (i >> 1);
            attn_body::attn_unit<8>(bh >> 3, bh & 7, qb, Qp, Kp, KRp, Vp, Op, shm, wave_s); }
        else { const int item = x + 8 * (int)(e - 64u); Ctx C = C0; C.lane = lane_now(); C.tid = wave_s * 64 + C.lane; decode_item(A, C, item >> 2, item & 3); LBAR(); }
    }
}
__global__ void __launch_bounds__(NWAVES * 64, 2) mk_fwd(Args args_unused) {
    extern __shared__ __attribute__((aligned(16))) unsigned char lds_raw[];
    const int wave_s = __builtin_amdgcn_readfirstlane(threadIdx.x >> 6);
    const int G_s = gridDim.x; const int vcu_s = (G_s % 8 == 0) ? ((int)blockIdx.x % 8) * (G_s / 8) + (int)blockIdx.x / 8 : (int)blockIdx.x;
#define MKCTX() Ctx C; C.lds = (LAS unsigned char*)lds_raw; C.wave = wave_s; C.lane = lane_now(); C.tid = wave_s * 64 + C.lane; C.G = G_s; C.vcu = vcu_s
#define T0() (wave_s == 0 && lane_now() == 0)
    volatile LAS unsigned* MISC = (volatile LAS unsigned*)((LAS unsigned char*)lds_raw + MISC_OFF);
    if (wave_s == 0) MISC[lane_now()] = 0u;
    __syncthreads();
    int lo, hi; gu32* ctl; { kargs_t A0 = KARGS(); lo = A0->ph_lo; hi = A0->ph_hi; ctl = (gu32*)(A0->ws + WS_CTL); }
    const bool multi = (hi - lo) > 1;
    XcdBarrier bar; bar.bar = (unsigned*)(ctl + CW_BAR); bar.x = 0; bar.st = nullptr;
    if (multi) bar = xcd_barrier_post((unsigned*)(ctl + CW_BAR), MISC, T0());
#ifndef PH_MASK
#define PH_MASK 0x7ff
#endif
#define IN(k) (((PH_MASK >> (k)) & 1) && lo <= (k) && (k) < hi)
#ifndef REP_MASK
#define REP_MASK 0
#endif
#define REP(k) for (int rep_ = 0; rep_ < 1 + ((REP_MASK >> (k)) & 1); ++rep_)
#define SEAM(k) do { if (IN(k) && IN((k) + 1)) xcd_barrier(bar, T0()); } while (0)

    if (IN(0)) REP(0) { MKCTX(); p0_prologue(KARGS(), C); }
    SEAM(0);
    if (IN(1)) REP(1) { MKCTX(); unsigned char* ws = KARGS()->ws;
        pg8::Gemm g{(const bf16*)(ws + WS_XN), (const bf16*)(ws + WS_WIN), MT, NZ, DM}; pg8::StaticOrder S; S.init(MT, NZ, C.G, (int)blockIdx.x);
        pg8::EpiBf16<0> E{(bf16*)(ws + WS_Z), NZ, nullptr, 0, 0, 1.f};
        pg8::gemm_phase<pg8::EpiBf16<0>, pg8::StaticOrder, PG8_ALIGN, PG8_SP2>(C.lds + RING_OFF, g, S, E, wave_s);
    }
    SEAM(1);
    if (IN(2)) REP(2) { MKCTX(); p2_post(KARGS(), C); }
    SEAM(2);
    if (IN(3)) REP(3) { MKCTX(); unsigned char* ws = KARGS()->ws;
#ifndef NO_QUP
        { pg8::Gemm g{(const bf16*)(ws + WS_CQN), (const bf16*)(ws + WS_WQUP), MT, NQ, QRK}; pg8::StaticOrder S; S.init(MT, NQ, C.G, (int)blockIdx.x);
          pg8::EpiQ E{(bf16*)(ws + WS_Q), (const float*)(ws + WS_ROPE), QSCALE};
          pg8::gemm_phase<pg8::EpiQ, pg8::StaticOrder, PG8_ALIGN, PG8_SP2>(C.lds + RING_OFF, g, S, E, wave_s); }
#endif
#ifndef NO_KV
        { pg8::Gemm g{(const bf16*)(ws + WS_CKVB), (const bf16*)(ws + WS_WKV), MP, 1024, 256}; pg8::StaticOrder S; S.init(MP, 1024, C.G, (int)blockIdx.x);
          pg8::EpiBf16<0> E{(bf16*)(ws + WS_KN), 512, nullptr, 512, (size_t)(WS_VH - WS_KN) / 2, 1.f};
          pg8::gemm_phase<pg8::EpiBf16<0>, pg8::StaticOrder, PG8_ALIGN, PG8_SP2>(C.lds + RING_OFF, g, S, E, wave_s); }
#endif
    }
    SEAM(3);
    if (IN(4)) { MKCTX(); kargs_t A4 = KARGS(); unsigned char* ws = A4->ws;
        static_assert(attn_body::ATTN_LDS_BYTES <= RING_BYTES, "attention body LDS");
        (void)ws; p4_queue(A4, C, ctl, (int)blockIdx.x, wave_s, (char*)lds_raw + RING_OFF);
    }
    SEAM(4);
    if (IN(5)) REP(5) { MKCTX(); p5_gate(KARGS(), C); }
    SEAM(5);
    if (IN(6)) REP(6) { MKCTX(); kargs_t A6 = KARGS(); unsigned char* ws = A6->ws;
        { pg8::Gemm g{(const bf16*)(ws + WS_MG), (const bf16*)(ws + WS_WOUT), MP, DM, DM}; pg8::StaticOrder S; S.init(MP, DM, C.G, (int)blockIdx.x);
          pg8::EpiResF32 E{A6->in[0], A6->in[1], (float*)(ws + WS_X1), DM};
          pg8::gemm_phase<pg8::EpiResF32, pg8::StaticOrder, PG8_ALIGN, PG8_SP2>(C.lds + RING_OFF, g, S, E, wave_s); }
        { pg8::Gemm g{(const bf16*)(ws + WS_MG) + (size_t)MP * DM, (const bf16*)(ws + WS_WOUT), MS, DM, 256, DM}; pg8::SplitKOrder S; S.init(MS, DM, 4, C.G, (int)blockIdx.x);
          pg8::EpiSlab E{(float*)(ws + WS_SLAB), MS, DM};
          pg8::gemm_phase<pg8::EpiSlab, pg8::SplitKOrder, PG8_ALIGN, PG8_SP2>(C.lds + RING_OFF, g, S, E, wave_s); }
    }
    SEAM(6);
    if (IN(7)) REP(7) { MKCTX(); p7_xn2(KARGS(), C); }
    SEAM(7);
    if (IN(8)) REP(8) { MKCTX(); unsigned char* ws = KARGS()->ws;
        pg8::Gemm g{(const bf16*)(ws + WS_XN2), (const bf16*)(ws + WS_WGU), MT, NGU, DM}; pg8::StaticOrder S; S.init(MT, NGU, C.G, (int)blockIdx.x);
        pg8::EpiSwiGLU E{(bf16*)(ws + WS_H), FFN};
        pg8::gemm_phase<pg8::EpiSwiGLU, pg8::StaticOrder, PG8_ALIGN, PG8_SP2>(C.lds + RING_OFF, g, S, E, wave_s);
    }
    SEAM(8);
    if (IN(9)) REP(9) { MKCTX(); kargs_t A9 = KARGS(); unsigned char* ws = A9->ws;
        { pg8::Gemm g{(const bf16*)(ws + WS_H), (const bf16*)(ws + WS_WDN), MP, DM, FFN}; pg8::StaticOrder S; S.init(MP, DM, C.G, (int)blockIdx.x);
          pg8::EpiResF32 E{(const float*)(ws + WS_X1), (const float*)(ws + WS_X1) + (size_t)MP * DM, A9->out + O_Y, DM};
          pg8::gemm_phase<pg8::EpiResF32, pg8::StaticOrder, PG8_ALIGN, PG8_SP2>(C.lds + RING_OFF, g, S, E, wave_s); }
        { pg8::Gemm g{(const bf16*)(ws + WS_H) + (size_t)MP * FFN, (const bf16*)(ws + WS_WDN), MS, DM, 256, FFN}; pg8::SplitKOrder S; S.init(MS, DM, 11, C.G, (int)blockIdx.x);
          pg8::EpiSlab E{(float*)(ws + WS_SLAB), MS, DM};
          pg8::gemm_phase<pg8::EpiSlab, pg8::SplitKOrder, PG8_ALIGN, PG8_SP2>(C.lds + RING_OFF, g, S, E, wave_s); }
    }
    SEAM(9);
    if (IN(10)) { MKCTX(); p10_final(KARGS(), C); }
#undef IN
#undef SEAM
#undef MKCTX
#undef REP
#undef T0
}

extern "C" void kernel_launch(void* const* d_in, const int* in_sizes, int n_in, void* d_out, int out_size, void* d_ws, size_t ws_size, hipStream_t stream) {
    static int grid = 0;
    if (grid == 0) {
        if (n_in != 24 || (size_t)out_size != O_END || ws_size < WS_END) { fprintf(stderr, "kernel_launch: unexpected problem (n_in %d, out %d, ws %zu); nothing launched\n", n_in, out_size, ws_size); grid = -1; return; }
        int dev = 0, cus = 0, per_cu = 0;
        if (hipGetDevice(&dev) != hipSuccess || hipDeviceGetAttribute(&cus, hipDeviceAttributeMultiprocessorCount, dev) != hipSuccess) { grid = -1; return; }
        if (hipFuncSetAttribute((const void*)mk_fwd, hipFuncAttributeMaxDynamicSharedMemorySize, LDS_BYTES) != hipSuccess) { fprintf(stderr, "kernel_launch: hipFuncSetAttribute failed\n"); grid = -1; return; }
        if (hipOccupancyMaxActiveBlocksPerMultiprocessor(&per_cu, (const void*)mk_fwd, NWAVES * 64, LDS_BYTES) != hipSuccess || per_cu < 1) { fprintf(stderr, "kernel_launch: occupancy query says %d\n", per_cu); }
        (void)hipGetLastError();
        grid = cus;
        if (grid != 256) fprintf(stderr, "kernel_launch: %d CUs (built for 256)\n", grid);
    }
    if (grid < 0) return;
    (void)hipMemsetAsync((char*)d_ws + WS_CTL, 0, CTL_ZERO_BYTES, stream);
    Args a{};
    for (int i = 0; i < 24; ++i) a.in[i] = (const float*)d_in[i];
    a.out = (float*)d_out; a.ws = (unsigned char*)d_ws;
#if MK_N_LAUNCHES == 1
    a.ph_lo = 0; a.ph_hi = N_PHASES;
    hipLaunchKernelGGL(mk_fwd, dim3(grid), dim3(NWAVES * 64), LDS_BYTES, stream, a);
#else
    for (int p = 0; p < N_PHASES; ++p) { a.ph_lo = p; a.ph_hi = p + 1; hipLaunchKernelGGL(mk_fwd, dim3(grid), dim3(NWAVES * 64), LDS_BYTES, stream, a); }
#endif
}
```
